# Optimizing an MI355X kernel written in HIP

```python
import math
import jax, jax.numpy as jnp
from jax import lax
import numpy as np

D_MODEL = 1024
BATCH = 8
SEQ = 2048
DEPTH = 4

N_MEM = 256
EPS = 1e-6
NEG_INF = -1e30
Q_BLOCK = 128

DIFF_HEADS = 8
DIFF_QK_DIM = 64
DIFF_V_DIM = 2 * DIFF_QK_DIM
DIFF_QK_WIDTH = 2 * DIFF_HEADS * DIFF_QK_DIM
DIFF_WIDTH = DIFF_HEADS * DIFF_V_DIM

DIL_GROUPS = ((128, 1), (512, 4), (2048, 16))
N_DIL_GROUPS = len(DIL_GROUPS)
DIL_HEADS = 4
DIL_HEAD_DIM = 128
DIL_WIDTH = DIL_HEADS * DIL_HEAD_DIM
DIL_QKV_WIDTH = N_DIL_GROUPS * DIL_WIDTH

MEM_HEADS = 4
MEM_HEAD_DIM = 128
MEM_WIDTH = MEM_HEADS * MEM_HEAD_DIM

N_BRANCH = 3

REL_BUCKETS = 32
REL_MAX_DIST = 1024
N_BIAS_HEADS = DIFF_HEADS + N_DIL_GROUPS * DIL_HEADS

IN_SIZES = (DIFF_QK_WIDTH, DIFF_QK_WIDTH, DIFF_WIDTH, DIFF_WIDTH,
            DIL_QKV_WIDTH, DIL_QKV_WIDTH, DIL_QKV_WIDTH, DIL_WIDTH,
            MEM_WIDTH, MEM_WIDTH, N_BRANCH * D_MODEL)
N_IN = sum(IN_SIZES)

kernel_name = 'hybrid_gated_diff_dilated_mem_encoder'


def rmsnorm(x, g=None):
    xf = x.astype(jnp.float32)
    y = xf * lax.rsqrt(jnp.mean(xf * xf, axis=-1, keepdims=True) + EPS)
    if g is not None:
        y = y * g.astype(jnp.float32)
    return y.astype(x.dtype)


def t5_bucket(rel):
    half = REL_BUCKETS // 2
    max_exact = half // 2
    ret = jnp.where(rel > 0, half, 0)
    n = jnp.abs(rel)
    nf = jnp.maximum(n, 1).astype(jnp.float32)
    large = max_exact + (jnp.log(nf / max_exact) / math.log(REL_MAX_DIST / max_exact)
                         * (half - max_exact)).astype(jnp.int32)
    large = jnp.minimum(large, half - 1)
    return ret + jnp.where(n < max_exact, n, large)


def diff_attention(q, k, v, lam, bias_tab):
    B, S = q.shape[0], q.shape[1]
    nq = S // Q_BLOCK
    scale = DIFF_QK_DIM ** -0.5
    qb = q.reshape(B, nq, Q_BLOCK, 2, DIFF_HEADS, DIFF_QK_DIM).transpose(1, 0, 2, 3, 4, 5)
    kpos = jnp.arange(S, dtype=jnp.int32)

    def one_block(args):
        qblk, i = args
        qpos = i * Q_BLOCK + jnp.arange(Q_BLOCK, dtype=jnp.int32)
        bias = bias_tab[t5_bucket(kpos[None, :] - qpos[:, None])]
        bias = jnp.transpose(bias, (2, 0, 1)).astype(jnp.float32)
        s = jnp.einsum('bqmhd,bkmhd->bmhqk', qblk, k,
                       preferred_element_type=jnp.float32) * scale + bias
        p = jax.nn.softmax(s, axis=-1)
        w = p[:, 0] - lam * p[:, 1]
        return jnp.einsum('bhqk,bkhe->bqhe', w.astype(v.dtype), v)

    out = lax.map(one_block, (qb, jnp.arange(nq, dtype=jnp.int32)))
    return out.transpose(1, 0, 2, 3, 4).reshape(B, S, DIFF_HEADS, DIFF_V_DIM)


def dilated_group(q, k, v, window, dilation, bias_tab):
    B, S, H, dh = q.shape
    r = dilation
    half = window // (2 * r)
    nb = half
    L = S // r
    nblk = -(-L // nb)
    Lp = nblk * nb
    Bn = B * r
    scale = dh ** -0.5

    def to_strided(t):
        return t.reshape(B, L, r, H, dh).transpose(0, 2, 1, 3, 4).reshape(Bn, L, H, dh)

    def band(t):
        tp = jnp.pad(t, ((0, 0), (nb, Lp - L + nb), (0, 0), (0, 0)))
        tp = tp.reshape(Bn, nblk + 2, nb, H, dh)
        return jnp.concatenate([tp[:, :-2], tp[:, 1:-1], tp[:, 2:]], axis=2)

    qs = jnp.pad(to_strided(q), ((0, 0), (0, Lp - L), (0, 0), (0, 0))).reshape(Bn, nblk, nb, H, dh)
    kb = band(to_strided(k))
    vb = band(to_strided(v))

    qi = jnp.arange(nb, dtype=jnp.int32)
    kj = jnp.arange(3 * nb, dtype=jnp.int32) - nb
    delta = kj[None, :] - qi[:, None]
    ksub = jnp.arange(nblk, dtype=jnp.int32)[:, None] * nb + kj[None, :]
    valid = (jnp.abs(delta) <= half)[None, :, :] & ((ksub >= 0) & (ksub < L))[:, None, :]
    bias = bias_tab[t5_bucket(delta * r)].astype(jnp.float32).transpose(2, 0, 1)

    s = jnp.einsum('bnqhd,bnkhd->bnhqk', qs, kb,
                   preferred_element_type=jnp.float32) * scale + bias
    s = jnp.where(valid[None, :, None], s, NEG_INF)
    m = jnp.max(s, axis=-1, keepdims=True)
    e = jnp.exp(s - m)
    den = jnp.sum(e, axis=-1, keepdims=True)
    o = jnp.einsum('bnhqk,bnkhd->bnqhd', (e / den).astype(v.dtype), vb)
    lse = (m + jnp.log(den))[..., 0]

    o = o.reshape(Bn, Lp, H, dh)[:, :L]
    lse = lse.transpose(0, 1, 3, 2).reshape(Bn, Lp, H)[:, :L]
    o = o.reshape(B, r, L, H, dh).transpose(0, 2, 1, 3, 4).reshape(B, S, H, dh)
    lse = lse.reshape(B, r, L, H).transpose(0, 2, 1, 3).reshape(B, S, H)
    return o, lse


def memory_attention(q, mk, mv):
    s = jnp.einsum('bshd,bmhd->bhsm', q, mk,
                   preferred_element_type=jnp.float32) * (MEM_HEAD_DIM ** -0.5)
    p = jax.nn.softmax(s, axis=-1)
    return jnp.einsum('bhsm,bmhd->bshd', p.astype(mv.dtype), mv)


def mixer_layer(x, mem, layer_idx, g_norm, w_in, lam_p, w_mem_kv, g_mem,
                w_br_diff, w_br_dil, w_br_mem, w_out, rel_bias):
    B, S, _ = x.shape
    h = rmsnorm(x, g_norm)
    z = jnp.einsum('bsd,dn->bsn', h, w_in)
    splits = np.cumsum(IN_SIZES)[:-1].tolist()
    dq, dk, dv, dg, lq, lk, lv, lg, mq, mg, mgate = jnp.split(z, splits, axis=-1)

    lam_init = 0.8 - 0.6 * math.exp(-0.3 * layer_idx)
    lp = lam_p.astype(jnp.float32)
    lam = jnp.exp(jnp.dot(lp[0], lp[1])) - jnp.exp(jnp.dot(lp[2], lp[3])) + lam_init
    o_a = diff_attention(dq.reshape(B, S, 2, DIFF_HEADS, DIFF_QK_DIM),
                         dk.reshape(B, S, 2, DIFF_HEADS, DIFF_QK_DIM),
                         dv.reshape(B, S, DIFF_HEADS, DIFF_V_DIM),
                         lam, rel_bias[:, :DIFF_HEADS])
    o_a = rmsnorm(o_a) * (1.0 - lam_init)
    y_a = jnp.einsum('bse,ed->bsd', o_a.reshape(B, S, DIFF_WIDTH) * jax.nn.silu(dg), w_br_diff)

    lq = lq.reshape(B, S, N_DIL_GROUPS, DIL_HEADS, DIL_HEAD_DIM)
    lk = lk.reshape(B, S, N_DIL_GROUPS, DIL_HEADS, DIL_HEAD_DIM)
    lv = lv.reshape(B, S, N_DIL_GROUPS, DIL_HEADS, DIL_HEAD_DIM)
    outs, lses = [], []
    for g, (window, dilation) in enumerate(DIL_GROUPS):
        c0 = DIFF_HEADS + g * DIL_HEADS
        o_g, lse_g = dilated_group(lq[:, :, g], lk[:, :, g], lv[:, :, g], window, dilation,
                                   rel_bias[:, c0:c0 + DIL_HEADS])
        outs.append(o_g.astype(jnp.float32))
        lses.append(lse_g)
    wts = jax.nn.softmax(jnp.stack(lses, axis=0), axis=0)
    o_b = jnp.einsum('gbsh,gbshe->bshe', wts, jnp.stack(outs, axis=0)).astype(x.dtype)
    y_b = jnp.einsum('bse,ed->bsd', o_b.reshape(B, S, DIL_WIDTH) * jax.nn.silu(lg), w_br_dil)

    mem_n = rmsnorm(mem, g_mem)
    kv = jnp.einsum('bmd,dn->bmn', mem_n, w_mem_kv).reshape(B, mem.shape[1], 2, MEM_HEADS, MEM_HEAD_DIM)
    o_m = memory_attention(mq.reshape(B, S, MEM_HEADS, MEM_HEAD_DIM), kv[:, :, 0], kv[:, :, 1])
    y_m = jnp.einsum('bse,ed->bsd', o_m.reshape(B, S, MEM_WIDTH) * jax.nn.silu(mg), w_br_mem)

    gates = jax.nn.sigmoid(mgate).reshape(B, S, N_BRANCH, D_MODEL)
    merged = gates[:, :, 0] * y_a + gates[:, :, 1] * y_b + gates[:, :, 2] * y_m
    return x + jnp.einsum('bsd,de->bse', merged, w_out)


def setup_inputs(seed: int = 0) -> dict:
    key = jax.random.key(seed)
    ks = jax.random.split(key, 14)
    f32 = jnp.float32
    nrm = jax.random.normal
    return {
        'x': nrm(ks[0], (BATCH, SEQ, D_MODEL), f32),
        'mem': nrm(ks[1], (BATCH, N_MEM, D_MODEL), f32),
        'g_norm': 1.0 + 0.02 * nrm(ks[2], (DEPTH, D_MODEL), f32),
        'w_in': nrm(ks[3], (DEPTH, D_MODEL, N_IN), f32) * D_MODEL ** -0.5,
        'diff_lambda': 0.1 * nrm(ks[4], (DEPTH, 4, DIFF_QK_DIM), f32),
        'w_mem_kv': nrm(ks[5], (DEPTH, D_MODEL, 2 * MEM_WIDTH), f32) * D_MODEL ** -0.5,
        'g_mem': 1.0 + 0.02 * nrm(ks[6], (DEPTH, D_MODEL), f32),
        'w_br_diff': nrm(ks[7], (DEPTH, DIFF_WIDTH, D_MODEL), f32) * DIFF_WIDTH ** -0.5,
        'w_br_dil': nrm(ks[8], (DEPTH, DIL_WIDTH, D_MODEL), f32) * DIL_WIDTH ** -0.5,
        'w_br_mem': nrm(ks[9], (DEPTH, MEM_WIDTH, D_MODEL), f32) * MEM_WIDTH ** -0.5,
        'w_out': nrm(ks[10], (DEPTH, D_MODEL, D_MODEL), f32) * D_MODEL ** -0.5,
        'rel_bias': 0.2 * nrm(ks[11], (REL_BUCKETS, N_BIAS_HEADS), f32),
        'g_final': 1.0 + 0.02 * nrm(ks[12], (D_MODEL,), f32),
    }


def reference(x, mem, g_norm, w_in, diff_lambda, w_mem_kv, g_mem,
              w_br_diff, w_br_dil, w_br_mem, w_out, rel_bias, g_final):
    for l in range(DEPTH):
        x = mixer_layer(x, mem, l, g_norm[l], w_in[l], diff_lambda[l], w_mem_kv[l], g_mem[l],
                        w_br_diff[l], w_br_dil[l], w_br_mem[l], w_out[l], rel_bias)
    return rmsnorm(x, g_final)
```

```cpp
#include <hip/hip_runtime.h>
#include <hip/hip_cooperative_groups.h>
#include <cstdio>
#include <cstdint>
namespace cg = cooperative_groups;
#define PROBE_DUP_DIFF 1
#define PROBE_DUP_IN 1
#define PROBE_DUP_SYNC 1
#define PROBE_DUP_P0 1
#define PROBE_DUP_B1 1
#define PROBE_DUP_PC 1
#define GSYNC() do { for (int rep_ = 0; rep_ < PROBE_DUP_SYNC; ++rep_) xcd_barrier(xbar); } while (0)

namespace pg8 {
#define PG8_LAS __attribute__((address_space(3)))
typedef unsigned short bf16_t;
typedef short bf16x8 __attribute__((ext_vector_type(8)));
typedef float f32x4 __attribute__((ext_vector_type(4)));
typedef unsigned u32x4 __attribute__((ext_vector_type(4)));
constexpr int BM = 256, BK = 64, HALF = 128, HTB = HALF * BK * 2  , STAGE_BYTES = 8 * HTB, NXCD = 8, WGM = 8;

__host__ __device__ __forceinline__ int lds_byte(int r, int c) { const int st = (r >> 4) * 2 + (c >> 5), rr = r & 15, cc = c & 31, ob = rr * 64 + cc * 2; return st * 1024 + (ob ^ (((ob >> 9) & 1) << 5)); }
__host__ __device__ __forceinline__ void stage_rc(int b, int& R, int& C) { const int st = b / 1024, sb = b % 1024, swz = sb ^ (((sb >> 9) & 1) << 5); R = (st >> 1) * 16 + swz / 64; C = (st & 1) * 32 + (swz % 64) / 2; }
__host__ __device__ __forceinline__ int perm32(int rho) { const int n = rho >> 4, i = rho & 15; return 8 * (i >> 2) + 4 * n + (i & 3); }

struct Unit { int pm, pn, seg; };
struct Gemm { const bf16_t* A; const bf16_t* Bt; int M, N, K; };

struct StaticOrder {
    int nM, nN, nwg, G, c;
    __host__ __device__ void init(int M, int N, int G_, int c_) { nM = M / BM; nN = N / BM; nwg = nM * nN; G = G_; c = c_; }
    __host__ __device__ bool next(int i, Unit& u) const {
        const long L = (long)i * G + c; if (L >= nwg) return false;
        int wgid = (int)L; { const int q = nwg / NXCD, r = nwg % NXCD, xcd = wgid % NXCD, off = wgid / NXCD; wgid = (xcd < r ? xcd * (q + 1) : r * (q + 1) + (xcd - r) * q) + off; }
        const int nig = WGM * nN, gid = wgid / nig, fm = gid * WGM, gsz = (nM - fm) < WGM ? (nM - fm) : WGM;
        u.pm = fm + ((wgid % nig) % gsz); u.pn = (wgid % nig) / gsz; u.seg = 0; return true;
    }
    __device__ __forceinline__ void a_ready(const Unit&) const {}
    __device__ __forceinline__ void done(const Unit&) const {}
};
template <class Epi, class Sched>
__device__ __forceinline__ void gemm_phase(PG8_LAS unsigned char* lds, const Gemm g, const Sched& S, const Epi& E) {
    int tid_l = threadIdx.x; asm volatile("" : "+v"(tid_l));
    const int tid = tid_l, wid = __builtin_amdgcn_readfirstlane(tid >> 6), lane = tid & 63, wr = wid >> 2, wc = wid & 3, fr = lane & 15, fq = lane >> 4;
    const int K = g.K, nt = K / BK;
    const int LD = Epi::KEEP_ACC ? 2048 : K; constexpr int SEGB = Epi::KEEP_ACC ? 1024 : 0;
    unsigned voffA[2], voffB[2];
#pragma unroll
    for (int i = 0; i < 2; ++i) { int R, C; stage_rc(tid * 16 + i * 8192, R, C); const int Rb = Epi::PERM ? ((R & ~31) + perm32(R & 31)) : R;
        voffA[i] = (unsigned)(R * LD + C) * 2u; voffB[i] = (unsigned)(Rb * LD + C) * 2u; }
    const size_t kstep = (size_t)(BK * 2);
    const size_t hstep = (size_t)HALF * LD * 2;
    const size_t tstep = 2 * hstep;
    const unsigned ldsw = (unsigned)wid * 1024u;
    const int aoff = lds_byte(wr * 64 + fr, fq * 8), boff = lds_byte(wc * 32 + fr, fq * 8);
#define PG8_SA(b, h) (((b) * 2 + (h)) * HTB)
#define PG8_SB(b, h) ((4 + (b) * 2 + (h)) * HTB)
#define PG8_STAGE(bufoff, gbase, voff) do { _Pragma("unroll") for (int _i = 0; _i < 2; ++_i) \
        __builtin_amdgcn_global_load_lds((const unsigned*)((const char*)(gbase) + (voff)[_i]), (PG8_LAS unsigned*)(lds + (bufoff) + ldsw + _i * 8192), 16, 0, 0); } while (0)
#define PG8_LDA(dst, b, h) do { _Pragma("unroll") for (int m = 0; m < 4; ++m) _Pragma("unroll") for (int k = 0; k < 2; ++k) dst[m][k] = *(const PG8_LAS bf16x8*)(lds + PG8_SA(b, h) + aoff + m * 2048 + k * 1024); } while (0)
#define PG8_LDB(dst, b, h) do { _Pragma("unroll") for (int n = 0; n < 2; ++n) _Pragma("unroll") for (int k = 0; k < 2; ++k) dst[n][k] = *(const PG8_LAS bf16x8*)(lds + PG8_SB(b, h) + boff + n * 2048 + k * 1024); } while (0)
#define PG8_MMA(ai, bj, At, Bt) do { __builtin_amdgcn_s_setprio(1); _Pragma("unroll") for (int m = 0; m < 4; ++m) _Pragma("unroll") for (int n = 0; n < 2; ++n) _Pragma("unroll") for (int k = 0; k < 2; ++k) \
        acc[ai][bj][m][n] = __builtin_amdgcn_mfma_f32_16x16x32_bf16(Bt[n][k], At[m][k], acc[ai][bj][m][n], 0, 0, 0); __builtin_amdgcn_s_setprio(0); } while (0)
#define PG8_WAIT_V(n) asm volatile("s_waitcnt vmcnt(" #n ")" ::: "memory")
#define PG8_WAIT_L(n) asm volatile("s_waitcnt lgkmcnt(" #n ")" ::: "memory")
#define PG8_BAR __builtin_amdgcn_s_barrier()
#define PG8_SCHED __builtin_amdgcn_sched_barrier(0)
    Unit cur, nxt; int ui = 0;
    if (!S.next(0, cur)) return;
    f32x4 acc[2][2][4][2];
#pragma unroll
    for (int a = 0; a < 2; ++a)
#pragma unroll
        for (int b = 0; b < 2; ++b)
#pragma unroll
            for (int m = 0; m < 4; ++m)
#pragma unroll
                for (int n = 0; n < 2; ++n) acc[a][b][m][n] = (f32x4){0.f, 0.f, 0.f, 0.f};
    if constexpr (Epi::HAS_INIT) E.init(acc, cur, wr, wc, fr, fq);
    bf16x8 At[4][2], B0[2][2], B1[2][2];
    const char* cA = (const char*)g.A + (size_t)cur.pm * tstep + (size_t)cur.seg * SEGB; const char* cB = (const char*)g.Bt + (size_t)cur.pn * tstep + (size_t)cur.seg * SEGB;
    S.a_ready(cur);
    PG8_STAGE(PG8_SB(0, 0), cB, voffB); PG8_STAGE(PG8_SA(0, 0), cA, voffA); PG8_STAGE(PG8_SB(0, 1), cB + hstep, voffB); PG8_STAGE(PG8_SA(0, 1), cA + hstep, voffA);
    if (wr == 1) PG8_BAR;
    PG8_WAIT_V(4); PG8_BAR;
    PG8_STAGE(PG8_SB(1, 0), cB + kstep, voffB); PG8_STAGE(PG8_SA(1, 0), cA + kstep, voffA); PG8_STAGE(PG8_SB(1, 1), cB + hstep + kstep, voffB);
    PG8_WAIT_V(6); PG8_BAR;
    for (;;) {
        const bool has_next = S.next(ui + 1, nxt);
        const char* nA = has_next ? (const char*)g.A + (size_t)nxt.pm * tstep + (size_t)nxt.seg * SEGB : cA; const char* nB = has_next ? (const char*)g.Bt + (size_t)nxt.pn * tstep + (size_t)nxt.seg * SEGB : cB;
        for (int t = 0; t < nt; t += 2) {
            const bool last = (t == nt - 2);
            const char* a1 = cA + (size_t)(t + 1) * kstep;
            const char* a2 = last ? nA : cA + (size_t)(t + 2) * kstep; const char* b2 = last ? nB : cB + (size_t)(t + 2) * kstep;
            const char* a3 = a2 + kstep; const char* b3 = b2 + kstep;
            if (last && has_next) S.a_ready(nxt);
            PG8_LDB(B0, 0, 0); PG8_SCHED; PG8_LDA(At, 0, 0); PG8_STAGE(PG8_SA(1, 1), a1 + hstep, voffA);
            PG8_WAIT_L(8); PG8_BAR; PG8_WAIT_L(0); PG8_MMA(0, 0, At, B0); PG8_BAR; PG8_SCHED;
            PG8_LDB(B1, 0, 1); PG8_STAGE(PG8_SB(0, 0), b2, voffB);
            PG8_BAR; PG8_WAIT_L(0); PG8_MMA(0, 1, At, B1); PG8_BAR;
            PG8_LDA(At, 0, 1); PG8_STAGE(PG8_SA(0, 0), a2, voffA);
            PG8_BAR; PG8_WAIT_L(0); PG8_MMA(1, 0, At, B0); PG8_BAR; PG8_SCHED;
            PG8_STAGE(PG8_SB(0, 1), b2 + hstep, voffB);
            PG8_WAIT_V(6); PG8_BAR; PG8_MMA(1, 1, At, B1); PG8_BAR;
            PG8_LDB(B0, 1, 0); PG8_SCHED; PG8_LDA(At, 1, 0); PG8_STAGE(PG8_SA(0, 1), a2 + hstep, voffA);
            PG8_WAIT_L(8); PG8_BAR; PG8_WAIT_L(0); PG8_MMA(0, 0, At, B0); PG8_BAR; PG8_SCHED;
            PG8_LDB(B1, 1, 1); PG8_STAGE(PG8_SB(1, 0), b3, voffB);
            PG8_BAR; PG8_WAIT_L(0); PG8_MMA(0, 1, At, B1); PG8_BAR;
            PG8_LDA(At, 1, 1); PG8_STAGE(PG8_SA(1, 0), a3, voffA);
            PG8_BAR; PG8_WAIT_L(0); PG8_MMA(1, 0, At, B0); PG8_BAR; PG8_SCHED;
            PG8_STAGE(PG8_SB(1, 1), b3 + hstep, voffB);
            PG8_WAIT_V(6); PG8_BAR; PG8_MMA(1, 1, At, B1); PG8_BAR;
        }
        if constexpr (!Epi::AFTER_DRAIN) { E(acc, cur, wr, wc, fr, fq); S.done(cur); }
        if (!has_next) break;
        if (!Epi::KEEP_ACC || cur.seg == 3)
#pragma unroll
        for (int a = 0; a < 2; ++a)
#pragma unroll
            for (int b = 0; b < 2; ++b)
#pragma unroll
                for (int m = 0; m < 4; ++m)
#pragma unroll
                    for (int n = 0; n < 2; ++n) acc[a][b][m][n] = (f32x4){0.f, 0.f, 0.f, 0.f};
        cur = nxt; cA = nA; cB = nB; ++ui;
        if constexpr (Epi::HAS_INIT) E.init(acc, cur, wr, wc, fr, fq);
    }
    PG8_WAIT_V(0);
    if (wr == 0) PG8_BAR;
    PG8_BAR;
    if constexpr (Epi::AFTER_DRAIN) { E.fused(acc, cur, wr, wc, fr, fq, lds, wid, lane); S.done(cur); }
#undef PG8_SA
#undef PG8_SB
#undef PG8_STAGE
#undef PG8_LDA
#undef PG8_LDB
#undef PG8_MMA
#undef PG8_WAIT_V
#undef PG8_WAIT_L
#undef PG8_BAR
#undef PG8_SCHED
}
}

#define LAS __attribute__((address_space(3)))
typedef unsigned short bf16;
typedef short v8s __attribute__((ext_vector_type(8)));
typedef short v4s __attribute__((ext_vector_type(4)));
typedef float v16f __attribute__((ext_vector_type(16)));
typedef float v4f __attribute__((ext_vector_type(4)));
typedef float v2f __attribute__((ext_vector_type(2)));
typedef unsigned v4u __attribute__((ext_vector_type(4)));
typedef unsigned v2u __attribute__((ext_vector_type(2)));
typedef __bf16 v2bf __attribute__((ext_vector_type(2)));

constexpr int NB = 8, SEQ = 2048, DM = 1024, T = NB * SEQ, DEPTH = 4, NMEM = 256, NIN = 13312;
constexpr int OFF_DQ = 0, OFF_DK = 1024, OFF_DV = 2048, OFF_DG = 3072, OFF_LQ = 4096, OFF_LK = 5632, OFF_LV = 7168, OFF_LG = 8704, OFF_MQ = 9216, OFF_MG = 9728, OFF_GATE = 10240;
constexpr float EPS = 1e-6f, LOG2E = 1.4426950408889634f, LN2 = 0.6931471805599453f, NEGBIG = -1e30f;

constexpr size_t MiB = 1u << 20;
constexpr size_t WS_WIN = 0;
constexpr size_t WS_WMKV = 104 * MiB;
constexpr size_t WS_WBD = 112 * MiB;
constexpr size_t WS_WBL = 120 * MiB;
constexpr size_t WS_WBM = 124 * MiB;
constexpr size_t WS_WOUT = 128 * MiB;
constexpr size_t WS_MEMN = 136 * MiB;
constexpr size_t WS_MEMK = 152 * MiB;
constexpr size_t WS_MEMVT = 160 * MiB;
constexpr size_t WS_TAB = 168 * MiB;
constexpr size_t WS_BAR = 168 * MiB + 768 * 1024;
constexpr size_t WS_H = 169 * MiB;
constexpr size_t WS_AA = 201 * MiB;
constexpr size_t WS_AB = 233 * MiB;
constexpr size_t WS_AM = 249 * MiB;
constexpr size_t WS_OG = 265 * MiB;
constexpr size_t WS_LSE = 313 * MiB;
constexpr size_t WS_DVT = 314 * MiB;
constexpr size_t WS_LVT = 346 * MiB;
constexpr size_t WS_Z = 394 * MiB;
constexpr size_t WS_END = 810 * MiB;
constexpr size_t WS_MERGED_F32 = WS_DVT;
constexpr size_t WS_MERGED_BF = WS_H;
static_assert(WS_Z + (size_t)T * NIN * 2 <= WS_END, "ws map");

constexpr int LDS_BYTES = 155648;
constexpr int LDS_MISC = 155392;

__device__ __forceinline__ unsigned pk2(float lo, float hi) { v2f v = {lo, hi}; return __builtin_bit_cast(unsigned, __builtin_convertvector(v, v2bf)); }
__device__ __forceinline__ float bflo(unsigned u) { return __uint_as_float(u << 16); }
__device__ __forceinline__ float bfhi(unsigned u) { return __uint_as_float(u & 0xffff0000u); }
__device__ __forceinline__ float wave_sum(float v) {
#pragma unroll
    for (int o = 1; o < 64; o <<= 1) v += __shfl_xor(v, o);
    return v;
}
__device__ __forceinline__ float silu_f(float x) { return x / (1.f + __expf(-x)); }
__device__ __forceinline__ float sigmoid_f(float x) { return 1.f / (1.f + __expf(-x)); }
#define MFMA32(a, b, c) __builtin_amdgcn_mfma_f32_32x32x16_bf16((a), (b), (c), 0, 0, 0)

struct Params {
    const float *x, *mem, *g_norm, *w_in, *diff_lambda, *w_mem_kv, *g_mem, *w_br_diff, *w_br_dil, *w_br_mem, *w_out, *rel_bias, *g_final;
    float* out; unsigned char* ws;
};

using pg8::f32x4;
using pg8::Unit;

__device__ __forceinline__ void seg_of(int ct, int& c0, int& w) {
    if (ct < OFF_LQ) { c0 = ct & ~1023; w = 1024; }
    else if (ct < OFF_LG) { const int k = (ct - OFF_LQ) / 1536; c0 = OFF_LQ + k * 1536; w = 1536; }
    else if (ct < OFF_GATE) { c0 = OFF_LG + ((ct - OFF_LG) & ~511); w = 512; }
    else { c0 = OFF_GATE; w = 3072; }
}
template <bool SEG> struct EpiInT {
    static constexpr bool PERM = true, AFTER_DRAIN = false, KEEP_ACC = false, HAS_INIT = false;
    bf16* Z; int ldz;
    __device__ __forceinline__ void operator()(const f32x4 (&acc)[2][2][4][2], const Unit& u, int wr, int wc, int fr, int fq) const {
        const int row0 = u.pm * 256 + wr * 64 + fr; int col0 = u.pn * 256 + wc * 32 + 8 * fq; int ld = ldz; bf16* base = Z;
        if (SEG) { int c0, w; seg_of(u.pn * 256, c0, w); base = Z + (size_t)T * c0; ld = w; col0 -= c0; }
#pragma unroll
        for (int ai = 0; ai < 2; ++ai)
#pragma unroll
            for (int m = 0; m < 4; ++m) { bf16* rowp = base + (size_t)(row0 + ai * 128 + m * 16) * ld + col0;
#pragma unroll
                for (int bj = 0; bj < 2; ++bj) { const f32x4 v0 = acc[ai][bj][m][0], v1 = acc[ai][bj][m][1];
                    v4u w; w.x = pk2(v0[0], v0[1]); w.y = pk2(v0[2], v0[3]); w.z = pk2(v1[0], v1[1]); w.w = pk2(v1[2], v1[3]);
                    *(v4u*)(rowp + bj * 128) = w; } }
    }
};

struct ChainOrder {
    pg8::StaticOrder S;
    __device__ __forceinline__ bool next(int i, Unit& u) const { if (!S.next(i >> 2, u)) return false; u.seg = i & 3; return true; }
    __device__ __forceinline__ void a_ready(const Unit&) const {}
    __device__ __forceinline__ void done(const Unit&) const {}
};
struct EpiMergeChain {
    static constexpr bool PERM = true, AFTER_DRAIN = false, KEEP_ACC = true, HAS_INIT = false;
    const bf16* Z; bf16* MB;
    static __device__ __forceinline__ float einv(float g) { return 1.f + __expf(fminf(-g, 30.f)); }
    __device__ __forceinline__ void operator()(f32x4 (&acc)[2][2][4][2], const Unit& u, int wr, int wc, int fr, int fq) const {
        const int row0 = u.pm * 256 + wr * 64 + fr, col0 = u.pn * 256 + wc * 32 + 8 * fq;
        if (u.seg == 0) return;
        if (u.seg < 3) {
            const int br = u.seg - 1;
#pragma unroll
            for (int ai = 0; ai < 2; ++ai)
#pragma unroll
                for (int m = 0; m < 4; ++m) { const bf16* zp = Z + (size_t)T * OFF_GATE + (size_t)(row0 + ai * 128 + m * 16) * 3072 + br * 1024 + col0;
#pragma unroll
                    for (int bj = 0; bj < 2; ++bj) { const v4u gc = *(const v4u*)(zp + bj * 128), gn = *(const v4u*)(zp + 1024 + bj * 128);
                        f32x4 r0, r1;
#define RAT(n_, c_) (einv(n_) * __builtin_amdgcn_rcpf(einv(c_)))
                        r0[0] = RAT(bflo(gn.x), bflo(gc.x)); r0[1] = RAT(bfhi(gn.x), bfhi(gc.x)); r0[2] = RAT(bflo(gn.y), bflo(gc.y)); r0[3] = RAT(bfhi(gn.y), bfhi(gc.y));
                        r1[0] = RAT(bflo(gn.z), bflo(gc.z)); r1[1] = RAT(bfhi(gn.z), bfhi(gc.z)); r1[2] = RAT(bflo(gn.w), bflo(gc.w)); r1[3] = RAT(bfhi(gn.w), bfhi(gc.w));
#undef RAT
                        acc[ai][bj][m][0] *= r0; acc[ai][bj][m][1] *= r1; } }
            return;
        }
#pragma unroll
        for (int ai = 0; ai < 2; ++ai) {
            v4u gq[4][2];
#pragma unroll
            for (int m = 0; m < 4; ++m)
#pragma unroll
                for (int bj = 0; bj < 2; ++bj) gq[m][bj] = *(const v4u*)(Z + (size_t)T * OFF_GATE + (size_t)(row0 + ai * 128 + m * 16) * 3072 + 2048 + col0 + bj * 128);
#pragma unroll
            for (int m = 0; m < 4; ++m) { const int row = row0 + ai * 128 + m * 16;
#pragma unroll
                for (int bj = 0; bj < 2; ++bj) { const int col = col0 + bj * 128;
                    const v4u gw = gq[m][bj];
                    const f32x4 a0 = acc[ai][bj][m][0], a1 = acc[ai][bj][m][1];
#define SG(a_, g_) ((a_) * __builtin_amdgcn_rcpf(einv(g_)))
                    v4u w; w.x = pk2(SG(a0[0], bflo(gw.x)), SG(a0[1], bfhi(gw.x))); w.y = pk2(SG(a0[2], bflo(gw.y)), SG(a0[3], bfhi(gw.y)));
                    w.z = pk2(SG(a1[0], bflo(gw.z)), SG(a1[1], bfhi(gw.z))); w.w = pk2(SG(a1[2], bflo(gw.w)), SG(a1[3], bfhi(gw.w)));
#undef SG
                    *(v4u*)(MB + (size_t)row * 1024 + col) = w; } }
        }
    }
};

struct EpiOut {
    static constexpr bool PERM = true, AFTER_DRAIN = false, KEEP_ACC = false, HAS_INIT = true;
    const float* XI; float* XO;
    __device__ __forceinline__ void init(f32x4 (&acc)[2][2][4][2], const Unit& u, int wr, int wc, int fr, int fq) const {
        const int row0 = u.pm * 256 + wr * 64 + fr, col0 = u.pn * 256 + wc * 32 + 8 * fq;
#pragma unroll
        for (int ai = 0; ai < 2; ++ai)
#pragma unroll
            for (int m = 0; m < 4; ++m) { const size_t ro = (size_t)(row0 + ai * 128 + m * 16) * 1024 + col0;
#pragma unroll
                for (int bj = 0; bj < 2; ++bj) { acc[ai][bj][m][0] = *(const f32x4*)(XI + ro + bj * 128); acc[ai][bj][m][1] = *(const f32x4*)(XI + ro + bj * 128 + 4); } }
    }
    __device__ __forceinline__ void operator()(const f32x4 (&acc)[2][2][4][2], const Unit& u, int wr, int wc, int fr, int fq) const {
        const int row0 = u.pm * 256 + wr * 64 + fr, col0 = u.pn * 256 + wc * 32 + 8 * fq;
#pragma unroll
        for (int ai = 0; ai < 2; ++ai)
#pragma unroll
            for (int m = 0; m < 4; ++m) { const size_t ro = (size_t)(row0 + ai * 128 + m * 16) * 1024 + col0;
#pragma unroll
                for (int bj = 0; bj < 2; ++bj) { *(f32x4*)(XO + ro + bj * 128) = acc[ai][bj][m][0]; *(f32x4*)(XO + ro + bj * 128 + 4) = acc[ai][bj][m][1]; } }
    }
};

__device__ __forceinline__ void p0_transpose_item(const float* W, int K, int N, bf16* WT, int ldT, LAS float* scr, int item, int lane) {
    const int nblk = N / 32, kb = item / nblk, nb = item % nblk, k0 = 64 * kb, n0 = 32 * nb;
#pragma unroll 16
    for (int i = 0; i < 32; ++i) { const int kk = 2 * i + (lane >> 5); scr[kk * 33 + (lane & 31)] = W[(size_t)(k0 + kk) * N + n0 + (lane & 31)]; }
    asm volatile("s_waitcnt lgkmcnt(0)" ::: "memory");
    const int c = lane & 7;
#pragma unroll
    for (int j = 0; j < 4; ++j) { const int n = (lane >> 3) + 8 * j; const LAS float* s = scr + (8 * c) * 33 + n;
        v4u o; o.x = pk2(s[0 * 33], s[1 * 33]); o.y = pk2(s[2 * 33], s[3 * 33]); o.z = pk2(s[4 * 33], s[5 * 33]); o.w = pk2(s[6 * 33], s[7 * 33]);
        *(v4u*)(WT + (size_t)(n0 + n) * ldT + k0 + 8 * c) = o; }
    asm volatile("s_waitcnt lgkmcnt(0)" ::: "memory");
}
__device__ __forceinline__ void rms_row_bf16(const float* xrow, const float* g, bf16* orow, int lane) {
    const v4f* xr = (const v4f*)xrow + lane; const v4f* gr = (const v4f*)g + lane;
    v4f v[4]; float s = 0.f;
#pragma unroll
    for (int j = 0; j < 4; ++j) { v[j] = xr[64 * j]; s += (v[j].x * v[j].x + v[j].y * v[j].y) + (v[j].z * v[j].z + v[j].w * v[j].w); }
    const float rstd = rsqrtf(wave_sum(s) * (1.f / 1024.f) + EPS);
    v2u* o8 = (v2u*)orow + lane;
#pragma unroll
    for (int j = 0; j < 4; ++j) { const v4f gv = gr[64 * j]; v2u o; o.x = pk2(v[j].x * rstd * gv.x, v[j].y * rstd * gv.y); o.y = pk2(v[j].z * rstd * gv.z, v[j].w * rstd * gv.w); o8[64 * j] = o; }
}
__device__ __forceinline__ void rms_row_f32(const float* xrow, const float* g, float* orow, int lane) {
    const v4f* xr = (const v4f*)xrow + lane; const v4f* gr = (const v4f*)g + lane;
    v4f v[4]; float s = 0.f;
#pragma unroll
    for (int j = 0; j < 4; ++j) { v[j] = xr[64 * j]; s += (v[j].x * v[j].x + v[j].y * v[j].y) + (v[j].z * v[j].z + v[j].w * v[j].w); }
    const float rstd = rsqrtf(wave_sum(s) * (1.f / 1024.f) + EPS);
    v4f* o = (v4f*)orow + lane;
#pragma unroll
    for (int j = 0; j < 4; ++j) { const v4f gv = gr[64 * j]; o[64 * j] = v[j] * rstd * gv; }
}
__device__ __forceinline__ int t5_bucket(int rel) {
    const int ret = rel > 0 ? 16 : 0; const int n = rel < 0 ? -rel : rel;
    const float nf = (float)(n > 1 ? n : 1);
    int large = 8 + (int)(logf(nf / 8.0f) / 4.852030263919617f * 8.0f);
    large = large < 15 ? large : 15;
    return ret + (n < 8 ? n : large);
}

template <int NM> struct AttnAcc { v16f O[NM][4]; float m[NM]; float l[NM]; };
struct BiasConst { float v; __device__ __forceinline__ float operator()(int) const { return v; } };
struct BiasToeplitz { const LAS float* tp; __device__ __forceinline__ float operator()(int i) const { return tp[(i & 3) + 8 * (i >> 2)]; } };
struct BiasBand { const LAS float* tab; int d0; __device__ __forceinline__ float operator()(int i) const { const int delta = d0 + (i & 3) + 8 * (i >> 2); const int ad = delta < 0 ? -delta : delta;
    const int idx = (delta < -64 ? -64 : (delta > 64 ? 64 : delta)) + 64; return ad <= 64 ? tab[idx] : NEGBIG; } };

template <int D, int NM, int KSTR, int VSTR, bool QLDS, class BF>
__device__ __forceinline__ void attn_subtile(const LAS unsigned char* K0, const LAS unsigned char* K1, const LAS unsigned char* Vb, const int kk,
                                             const v8s (&Q)[NM][D / 16], const LAS unsigned char* qlds, AttnAcc<NM>& st, const float c1, const BF& bias, const int r, const int h) {
    v8s P[NM][2];
#pragma unroll
    for (int m = 0; m < NM; ++m) {
        const LAS unsigned char* Kb = (m == 0 ? K0 : K1) + (32 * kk + r) * KSTR + h * 16;
        v16f S;
#pragma unroll
        for (int i = 0; i < 16; ++i) S[i] = 0.f;
        v8s kfa[D / 16];
#pragma unroll
        for (int ks = 0; ks < D / 16; ++ks) kfa[ks] = *(const LAS v8s*)(Kb + ks * 32);
        __builtin_amdgcn_sched_barrier(0);
#pragma unroll
        for (int ks = 0; ks < D / 16; ++ks) { const v8s qf = QLDS ? *(const LAS v8s*)(qlds + (m * (D / 16) + ks) * 1024) : Q[m][ks]; S = MFMA32(kfa[ks], qf, S); }
        __builtin_amdgcn_sched_barrier(0);
        float tmax = NEGBIG;
#pragma unroll
        for (int i = 0; i < 16; ++i) { S[i] = S[i] * c1 + bias(i); tmax = fmaxf(tmax, S[i]); }
        tmax = fmaxf(tmax, __shfl_xor(tmax, 32));
        const float mo = st.m[m], mn = fmaxf(mo, tmax);
        if (__any(mn > mo)) {
            const float alpha = __builtin_amdgcn_exp2f(mo - mn);
            st.l[m] *= alpha;
#pragma unroll
            for (int eb = 0; eb < 4; ++eb)
#pragma unroll
                for (int i = 0; i < 16; ++i) st.O[m][eb][i] *= alpha;
            st.m[m] = mn;
        }
        float ps = 0.f;
#pragma unroll
        for (int i = 0; i < 16; ++i) { S[i] = __builtin_amdgcn_exp2f(S[i] - mn); ps += S[i]; }
        st.l[m] += ps;
#pragma unroll
        for (int s2 = 0; s2 < 2; ++s2) { v4u w; w.x = pk2(S[8 * s2 + 0], S[8 * s2 + 1]); w.y = pk2(S[8 * s2 + 2], S[8 * s2 + 3]); w.z = pk2(S[8 * s2 + 4], S[8 * s2 + 5]); w.w = pk2(S[8 * s2 + 6], S[8 * s2 + 7]);
            P[m][s2] = __builtin_bit_cast(v8s, w); }
    }
    const int lane_ = h * 32 + r, q_ = (lane_ >> 2) & 3, p_ = lane_ & 3, g1_ = (lane_ >> 4) & 1;
    const LAS unsigned char* vb0 = Vb + ((32 * kk + 4 * h + q_) * VSTR + (16 * g1_ + 4 * p_) * 2);
#pragma unroll
    for (int s2 = 0; s2 < 2; ++s2) {
        const LAS unsigned char* va = vb0 + 16 * s2 * VSTR;
        v8s vfa[4];
#pragma unroll
        for (int eb = 0; eb < 4; ++eb) {
            const v4s lo = __builtin_amdgcn_ds_read_tr16_b64_v4i16((LAS v4s*)(va + 64 * eb)), hi = __builtin_amdgcn_ds_read_tr16_b64_v4i16((LAS v4s*)(va + 64 * eb + 8 * VSTR));
            vfa[eb] = __builtin_shufflevector(lo, hi, 0, 1, 2, 3, 4, 5, 6, 7); }
        __builtin_amdgcn_sched_barrier(0);
#pragma unroll
        for (int eb = 0; eb < 4; ++eb)
#pragma unroll
            for (int m = 0; m < NM; ++m) st.O[m][eb] = MFMA32(vfa[eb], P[m][s2], st.O[m][eb]);
        __builtin_amdgcn_sched_barrier(0);
    }
}
template <int NM> __device__ __forceinline__ void attn_init(AttnAcc<NM>& st) {
#pragma unroll
    for (int m = 0; m < NM; ++m) { st.m[m] = NEGBIG; st.l[m] = 0.f;
#pragma unroll
        for (int eb = 0; eb < 4; ++eb)
#pragma unroll
            for (int i = 0; i < 16; ++i) st.O[m][eb][i] = 0.f; }
}

constexpr int DF_K0 = 0, DF_K1 = 18432, DF_VT = 36864, DF_TAB = 77824, DF_Q = 83328;
__device__ __forceinline__ void diff_item(const Params& p, LAS unsigned char* lds, const int item, const int layer, const float lam, const float lam_init) {
    int tid_l = threadIdx.x; asm volatile("" : "+v"(tid_l));
    const int tid = tid_l, lane = tid & 63, wave = tid >> 6, r = lane & 31, h = lane >> 5;
    const int b = item >> 6, hh = (item >> 3) & 7, qb = item & 7;
    const bf16* Z = (const bf16*)(p.ws + WS_Z); bf16* AA = (bf16*)(p.ws + WS_AA);
    const float* gtab = (const float*)(p.ws + WS_TAB) + hh * 4096;
    LAS float* tab = (LAS float*)(lds + DF_TAB);
    const int q0w = qb * 256 + wave * 32; const size_t tq = (size_t)b * 2048 + q0w + r;
    __syncthreads();
    for (int i = tid; i < 1345; i += 512) tab[i] = gtab[i + 2047 - 672];
    LAS unsigned char* qlds = lds + DF_Q + wave * 8192 + lane * 16;
#pragma unroll
    for (int m = 0; m < 2; ++m)
#pragma unroll
        for (int ks = 0; ks < 4; ++ks) *(LAS v4u*)(qlds + (m * 4 + ks) * 1024) = *(const v4u*)(Z + tq * NIN + OFF_DQ + m * 512 + hh * 64 + ks * 16 + h * 8);
    v8s Qdummy[2][4];
#pragma unroll
    for (int m = 0; m < 2; ++m)
#pragma unroll
        for (int ks = 0; ks < 4; ++ks) Qdummy[m][ks] = (v8s){0, 0, 0, 0, 0, 0, 0, 0};
    AttnAcc<2> st; attn_init<2>(st);
    const int rowK = tid >> 3, cc = tid & 7, rowV = tid >> 4, ccV = tid & 15;
    const bf16* sK = Z + ((size_t)b * 2048 + rowK) * NIN + OFF_DK + hh * 64 + cc * 8;
    const bf16* sV = Z + ((size_t)b * 2048 + rowV) * NIN + OFF_DV + hh * 128 + ccV * 8;
    LAS unsigned char* dK0 = lds + DF_K0 + rowK * 144 + cc * 16; LAS unsigned char* dK1 = lds + DF_K1 + rowK * 144 + cc * 16;
    LAS unsigned char* dV = lds + DF_VT + rowV * 320 + ccV * 16;
    const float c1 = 0.125f * LOG2E;
    const float bpos = gtab[2047 + 1024], bneg = gtab[2047 - 1024];
    v4u g0 = *(const v4u*)sK, g1 = *(const v4u*)(sK + 512), g2 = *(const v4u*)sV, g3 = *(const v4u*)(sV + (size_t)32 * NIN);
#pragma unroll 1
    for (int t = 0; t < 32; ++t) {
        __syncthreads();
        *(LAS v4u*)dK0 = g0; *(LAS v4u*)dK1 = g1; *(LAS v4u*)dV = g2; *(LAS v4u*)(dV + 32 * 320) = g3;
        __syncthreads();
        if (t + 1 < 32) { const bf16* nK = sK + (size_t)(t + 1) * 64 * NIN; const bf16* nV = sV + (size_t)(t + 1) * 64 * NIN;
            g0 = *(const v4u*)nK; g1 = *(const v4u*)(nK + 512); g2 = *(const v4u*)nV; g3 = *(const v4u*)(nV + (size_t)32 * NIN); }
        const int k0 = t * 64;
#pragma unroll 1
        for (int kk = 0; kk < 2; ++kk) {
            const int lo_rel = k0 + 32 * kk - (q0w + 31), hi_rel = k0 + 32 * kk + 31 - q0w;
            if (lo_rel >= 600) { const BiasConst bf{bpos}; attn_subtile<64, 2, 144, 320, true>(lds + DF_K0, lds + DF_K1, lds + DF_VT, kk, Qdummy, qlds, st, c1, bf, r, h); }
            else if (hi_rel <= -600) { const BiasConst bf{bneg}; attn_subtile<64, 2, 144, 320, true>(lds + DF_K0, lds + DF_K1, lds + DF_VT, kk, Qdummy, qlds, st, c1, bf, r, h); }
            else { const BiasToeplitz bf{tab + (k0 + 32 * kk + 4 * h - (q0w + r) + 672)}; attn_subtile<64, 2, 144, 320, true>(lds + DF_K0, lds + DF_K1, lds + DF_VT, kk, Qdummy, qlds, st, c1, bf, r, h); }
        }
    }
    int item2 = item, tid2 = threadIdx.x; asm volatile("" : "+s"(item2), "+v"(tid2));
    const int b2 = item2 >> 6, hh2 = (item2 >> 3) & 7, qb2 = item2 & 7;
    const size_t tq2 = (size_t)b2 * 2048 + qb2 * 256 + (tid2 >> 6) * 32 + (tid2 & 31); const int h2 = (tid2 >> 5) & 1;
    const float l0 = st.l[0] + __shfl_xor(st.l[0], 32), l1 = st.l[1] + __shfl_xor(st.l[1], 32);
    const float i0 = 1.f / l0, i1 = lam / l1;
    float ss = 0.f;
#pragma unroll
    for (int eb = 0; eb < 4; ++eb)
#pragma unroll
        for (int i = 0; i < 16; ++i) { const float o = st.O[0][eb][i] * i0 - st.O[1][eb][i] * i1; st.O[0][eb][i] = o; ss += o * o; }
    ss += __shfl_xor(ss, 32);
    const float rn = rsqrtf(ss * (1.f / 128.f) + EPS) * (1.f - lam_init);
#pragma unroll
    for (int eb = 0; eb < 4; ++eb)
#pragma unroll
        for (int q4 = 0; q4 < 4; ++q4) { const int e0 = 32 * eb + 8 * q4 + 4 * h2;
            const v2u gw = *(const v2u*)(Z + tq2 * NIN + OFF_DG + hh2 * 128 + e0);
            v2u o; o.x = pk2(st.O[0][eb][4 * q4 + 0] * rn * silu_f(bflo(gw.x)), st.O[0][eb][4 * q4 + 1] * rn * silu_f(bfhi(gw.x)));
            o.y = pk2(st.O[0][eb][4 * q4 + 2] * rn * silu_f(bflo(gw.y)), st.O[0][eb][4 * q4 + 3] * rn * silu_f(bfhi(gw.y)));
            *(v2u*)(AA + tq2 * 2048 + hh2 * 128 + e0) = o; }
}

constexpr int STG_OFF = 83456, STG_WAVE = 8704;
__device__ __forceinline__ void stg_write(LAS unsigned char* wbuf, const v16f (&O)[4], const float scale, const int r, const int h) {
#pragma unroll
    for (int eb = 0; eb < 4; ++eb)
#pragma unroll
        for (int q4 = 0; q4 < 4; ++q4) { v2u o; o.x = pk2(O[eb][4 * q4 + 0] * scale, O[eb][4 * q4 + 1] * scale); o.y = pk2(O[eb][4 * q4 + 2] * scale, O[eb][4 * q4 + 3] * scale);
            *(LAS v2u*)(wbuf + r * 272 + (32 * eb + 8 * q4 + 4 * h) * 2) = o; }
}
__device__ __forceinline__ v4u gate_silu8(const v4u o, const v4u g) {
    v4u w;
    w.x = pk2(bflo(o.x) * silu_f(bflo(g.x)), bfhi(o.x) * silu_f(bfhi(g.x))); w.y = pk2(bflo(o.y) * silu_f(bflo(g.y)), bfhi(o.y) * silu_f(bfhi(g.y)));
    w.z = pk2(bflo(o.z) * silu_f(bflo(g.z)), bfhi(o.z) * silu_f(bfhi(g.z))); w.w = pk2(bflo(o.w) * silu_f(bflo(g.w)), bfhi(o.w) * silu_f(bfhi(g.w)));
    return w;
}
constexpr int D2_K1 = 9216, D2_KB = 18432, D2_VR = 36864, D2_VB = 20480, D2_TAB = 77824;
__device__ __forceinline__ void d2_qk(const LAS unsigned char* Kb, const v8s (&Q)[4], v16f& S) {
    const v16f z = {0.f, 0.f, 0.f, 0.f, 0.f, 0.f, 0.f, 0.f, 0.f, 0.f, 0.f, 0.f, 0.f, 0.f, 0.f, 0.f};
    const v8s k0 = *(const LAS v8s*)Kb, k1 = *(const LAS v8s*)(Kb + 32), k2 = *(const LAS v8s*)(Kb + 64), k3 = *(const LAS v8s*)(Kb + 96);
    __builtin_amdgcn_sched_barrier(0);
    S = MFMA32(k0, Q[0], z); S = MFMA32(k1, Q[1], S); S = MFMA32(k2, Q[2], S); S = MFMA32(k3, Q[3], S);
    __builtin_amdgcn_sched_barrier(0);
}
__device__ __forceinline__ void d2_softmax(v16f& S, const float c1, const LAS float* tp, float& m, float& l, v16f (&O)[4], v8s (&P)[2]) {
    float tmax = NEGBIG;
#pragma unroll
    for (int i = 0; i < 16; ++i) { S[i] = S[i] * c1 + tp[(i & 3) + 8 * (i >> 2)]; tmax = fmaxf(tmax, S[i]); }
    tmax = fmaxf(tmax, __shfl_xor(tmax, 32));
    const float mo = m;
    if (__any(tmax > mo + 8.f)) {
        const float mn = (tmax > mo + 8.f) ? tmax : mo;
        const float alpha = __builtin_amdgcn_exp2f(mo - mn);
        l *= alpha;
#pragma unroll
        for (int eb = 0; eb < 4; ++eb)
#pragma unroll
            for (int i = 0; i < 16; ++i) O[eb][i] *= alpha;
        m = mn;
    }
    const float mc = m;
    float ps = 0.f;
#pragma unroll
    for (int i = 0; i < 16; ++i) { S[i] = __builtin_amdgcn_exp2f(S[i] - mc); ps += S[i]; }
    l += ps;
#pragma unroll
    for (int s2 = 0; s2 < 2; ++s2) { v4u w; w.x = pk2(S[8 * s2 + 0], S[8 * s2 + 1]); w.y = pk2(S[8 * s2 + 2], S[8 * s2 + 3]); w.z = pk2(S[8 * s2 + 4], S[8 * s2 + 5]); w.w = pk2(S[8 * s2 + 6], S[8 * s2 + 7]);
        P[s2] = __builtin_bit_cast(v8s, w); }
}
#define TRR(p_) __builtin_amdgcn_ds_read_tr16_b64_v4i16((LAS v4s*)(p_))
__device__ __forceinline__ void d2_pv(const LAS unsigned char* vb0, const v8s (&P)[2], v16f (&O)[4]) {
    const LAS unsigned char* va = vb0; const LAS unsigned char* vc = vb0 + 16 * 320;
    const v4s l0 = TRR(va), h0 = TRR(va + 2560), l1 = TRR(va + 64), h1 = TRR(va + 2624), l2 = TRR(va + 128), h2 = TRR(va + 2688), l3 = TRR(va + 192), h3 = TRR(va + 2752);
    __builtin_amdgcn_sched_barrier(0);
    const v4s m0 = TRR(vc), n0 = TRR(vc + 2560), m1 = TRR(vc + 64), n1 = TRR(vc + 2624), m2 = TRR(vc + 128), n2 = TRR(vc + 2688), m3 = TRR(vc + 192), n3 = TRR(vc + 2752);
    O[0] = MFMA32(__builtin_shufflevector(l0, h0, 0, 1, 2, 3, 4, 5, 6, 7), P[0], O[0]);
    O[1] = MFMA32(__builtin_shufflevector(l1, h1, 0, 1, 2, 3, 4, 5, 6, 7), P[0], O[1]);
    O[2] = MFMA32(__builtin_shufflevector(l2, h2, 0, 1, 2, 3, 4, 5, 6, 7), P[0], O[2]);
    O[3] = MFMA32(__builtin_shufflevector(l3, h3, 0, 1, 2, 3, 4, 5, 6, 7), P[0], O[3]);
    __builtin_amdgcn_sched_barrier(0);
    O[0] = MFMA32(__builtin_shufflevector(m0, n0, 0, 1, 2, 3, 4, 5, 6, 7), P[1], O[0]);
    O[1] = MFMA32(__builtin_shufflevector(m1, n1, 0, 1, 2, 3, 4, 5, 6, 7), P[1], O[1]);
    O[2] = MFMA32(__builtin_shufflevector(m2, n2, 0, 1, 2, 3, 4, 5, 6, 7), P[1], O[2]);
    O[3] = MFMA32(__builtin_shufflevector(m3, n3, 0, 1, 2, 3, 4, 5, 6, 7), P[1], O[3]);
    __builtin_amdgcn_sched_barrier(0);
}
#define SB() __builtin_amdgcn_sched_barrier(0)
__device__ __forceinline__ void d2_ldk(const LAS unsigned char* Kb, v8s (&kf)[4]) {
#pragma unroll
    for (int ks = 0; ks < 4; ++ks) kf[ks] = *(const LAS v8s*)(Kb + ks * 32);
}
__device__ __forceinline__ void d2_mmk(const v8s (&kf)[4], const v8s (&Q)[4], v16f& S) {
    const v16f z = {0.f, 0.f, 0.f, 0.f, 0.f, 0.f, 0.f, 0.f, 0.f, 0.f, 0.f, 0.f, 0.f, 0.f, 0.f, 0.f};
    S = MFMA32(kf[0], Q[0], z);
#pragma unroll
    for (int ks = 1; ks < 4; ++ks) S = MFMA32(kf[ks], Q[ks], S);
}
__device__ __forceinline__ void d2_ldv(const LAS unsigned char* va, v8s (&vf)[4]) {
#pragma unroll
    for (int eb = 0; eb < 4; ++eb) { const v4s lo = TRR(va + 64 * eb), hi = TRR(va + 64 * eb + 8 * 320); vf[eb] = __builtin_shufflevector(lo, hi, 0, 1, 2, 3, 4, 5, 6, 7); }
}
__device__ __forceinline__ void d2_mmv(const v8s (&vf)[4], const v8s& P, v16f (&O)[4]) {
#pragma unroll
    for (int eb = 0; eb < 4; ++eb) O[eb] = MFMA32(vf[eb], P, O[eb]);
}
template <bool DOQK, bool DOPV>
__device__ __forceinline__ void d2_segY(const LAS unsigned char* kbase, const LAS unsigned char* vbase, const v8s (&Q)[4], v16f& S0, v16f& S1, const v8s (&P0)[2], const v8s (&P1)[2], v16f (&O)[4]) {
    if (DOQK) {
        { v8s f[4]; d2_ldk(kbase, f); SB(); d2_mmk(f, Q, S0); SB(); }
        { v8s f[4]; d2_ldk(kbase + 32 * 144, f); SB(); d2_mmk(f, Q, S1); SB(); }
    }
    if (DOPV) {
        { v8s f[4]; d2_ldv(vbase, f); SB(); d2_mmv(f, P0[0], O); SB(); }
        { v8s f[4]; d2_ldv(vbase + 16 * 320, f); SB(); d2_mmv(f, P0[1], O); SB(); }
        { v8s f[4]; d2_ldv(vbase + 32 * 320, f); SB(); d2_mmv(f, P1[0], O); SB(); }
        { v8s f[4]; d2_ldv(vbase + 48 * 320, f); SB(); d2_mmv(f, P1[1], O); SB(); }
    }
}
__device__ __forceinline__ void diff2_item(const Params& p, LAS unsigned char* lds, const int item, const float lam, const float lam_init) {
    int tid_l = threadIdx.x; asm volatile("" : "+v"(tid_l));
    const int tid = tid_l, lane = tid & 63, wave = tid >> 6, r = lane & 31, h = lane >> 5, mp = wave >> 2, qs = wave & 3;
    const int b = item >> 7, hh = (item >> 4) & 7, qb = item & 15;
    const bf16* Z = (const bf16*)(p.ws + WS_Z); bf16* AA = (bf16*)(p.ws + WS_AA);
    const float* gtab = (const float*)(p.ws + WS_TAB) + hh * 4096;
    LAS float* tab = (LAS float*)(lds + D2_TAB);
    const int q0w = qb * 128 + qs * 32; const size_t tq = (size_t)b * 2048 + q0w + r;
    __syncthreads();
    for (int i = tid; i < 1345; i += 512) tab[i] = gtab[i + 2047 - 672];
    v8s Q[4];
#pragma unroll
    for (int ks = 0; ks < 4; ++ks) Q[ks] = *(const v8s*)(Z + (size_t)T * OFF_DQ + tq * 1024 + mp * 512 + hh * 64 + ks * 16 + h * 8);
    v16f O[4]; float m_ = NEGBIG, l_ = 0.f;
#pragma unroll
    for (int eb = 0; eb < 4; ++eb)
#pragma unroll
        for (int i = 0; i < 16; ++i) O[eb][i] = 0.f;
    const int rowK = tid >> 3, cc = tid & 7, rowV = tid >> 4, ccV = tid & 15;
    const unsigned char* Zt = (const unsigned char*)(Z + (size_t)T * OFF_DK + ((size_t)b * 2048) * 1024 + hh * 64);
    const unsigned char* ZtV = (const unsigned char*)(Z + (size_t)T * OFF_DV + ((size_t)b * 2048) * 1024 + hh * 128);
    const unsigned oK = (unsigned)(rowK * 1024 + cc * 8) * 2u;
    const unsigned oV = (unsigned)(rowV * 1024 + ccV * 8) * 2u;
    LAS unsigned char* dK = lds + rowK * 144 + cc * 16;
    LAS unsigned char* dV = lds + D2_VR + rowV * 320 + ccV * 16;
#define D2_LOADK(tt) do { const unsigned char* zt_ = Zt + (size_t)(tt) * (64 * 1024 * 2); gk0 = *(const v4u*)(zt_ + oK); gk1 = *(const v4u*)(zt_ + oK + 1024); } while (0)
#define D2_LOADV(tt) do { const unsigned char* zt_ = ZtV + (size_t)(tt) * (64 * 1024 * 2); gv0 = *(const v4u*)(zt_ + oV); gv1 = *(const v4u*)(zt_ + oV + 32 * 1024 * 2); } while (0)
    v4u gk0, gk1, gv0, gv1;
    D2_LOADK(0);
    *(LAS v4u*)dK = gk0; *(LAS v4u*)(dK + D2_K1) = gk1;
    D2_LOADK(1); D2_LOADV(0);
    __syncthreads();
    const float c1 = 0.125f * LOG2E;
    const LAS unsigned char* kb0 = lds + mp * D2_K1 + r * 144 + h * 16;
    const int q_ = (lane >> 2) & 3, p_ = lane & 3, g1_ = (lane >> 4) & 1;
    const LAS unsigned char* vb_lane = lds + D2_VR + ((4 * h + q_) * 320 + (16 * g1_ + 4 * p_) * 2);
    const int rel0 = 4 * h - (q0w + r);
    v16f S0, S1; v8s P0[2], P1[2];
#define D2_X(t_) do { int i0_ = (t_) * 64 + rel0; i0_ = i0_ < -672 ? -672 : (i0_ > 640 ? 640 : i0_); d2_softmax(S0, c1, tab + (i0_ + 672), m_, l_, O, P0); \
                      int i1_ = (t_) * 64 + 32 + rel0; i1_ = i1_ < -672 ? -672 : (i1_ > 640 ? 640 : i1_); d2_softmax(S1, c1, tab + (i1_ + 672), m_, l_, O, P1); } while (0)
#define D2_Y(t_) do { if ((t_) + 1 < 32) { const LAS unsigned char* kb_ = kb0 + (((t_) + 1) & 1) * D2_KB; d2_qk(kb_, Q, S0); d2_qk(kb_ + 32 * 144, Q, S1); } \
                      if ((t_) >= 0) { const LAS unsigned char* vb_ = vb_lane + ((t_) & 1) * D2_VB; d2_pv(vb_, P0, O); d2_pv(vb_ + 32 * 320, P1, O); } } while (0)
    if (mp == 0) D2_Y(-1);
    __syncthreads();
#pragma unroll 1
    for (int t = 0; t < 32; ++t) {
        if (t + 1 < 32) { LAS unsigned char* d_ = dK + ((t + 1) & 1) * D2_KB; *(LAS v4u*)d_ = gk0; *(LAS v4u*)(d_ + D2_K1) = gk1; }
        { LAS unsigned char* d_ = dV + (t & 1) * D2_VB; *(LAS v4u*)d_ = gv0; *(LAS v4u*)(d_ + 32 * 320) = gv1; }
        if (t + 2 < 32) D2_LOADK(t + 2);
        if (t + 1 < 32) D2_LOADV(t + 1);
        if (mp == 0) D2_X(t); else D2_Y(t - 1);
        __syncthreads();
        if (mp == 0) D2_Y(t); else D2_X(t);
        __syncthreads();
    }
    if (mp == 1) D2_Y(31);
    __syncthreads();
    v4u gg[8];
    if (mp == 0) {
#pragma unroll
        for (int it = 0; it < 8; ++it) { const int row = it * 4 + (lane >> 4), ch = lane & 15; const size_t tr = (size_t)b * 2048 + q0w + row;
            gg[it] = *(const v4u*)(Z + (size_t)T * OFF_DG + tr * 1024 + hh * 128 + ch * 8); }
    }
    const float lt = l_ + __shfl_xor(l_, 32);
    LAS float* X = (LAS float*)(lds + qs * 16384) + lane;
    if (mp == 1) { const float i1 = lam / lt;
#pragma unroll
        for (int eb = 0; eb < 4; ++eb)
#pragma unroll
            for (int i = 0; i < 16; ++i) X[(eb * 16 + i) * 64] = O[eb][i] * i1; }
    __syncthreads();
    if (mp == 0) {
        const float i0 = 1.f / lt; float ss = 0.f;
#pragma unroll
        for (int eb = 0; eb < 4; ++eb)
#pragma unroll
            for (int i = 0; i < 16; ++i) { const float o = O[eb][i] * i0 - X[(eb * 16 + i) * 64]; O[eb][i] = o; ss += o * o; }
        ss += __shfl_xor(ss, 32);
        const float rn = rsqrtf(ss * (1.f / 128.f) + EPS) * (1.f - lam_init);
        LAS unsigned char* wbuf = lds + STG_OFF + qs * STG_WAVE;
        stg_write(wbuf, O, rn, r, h);
#pragma unroll
        for (int it = 0; it < 8; ++it) { const int row = it * 4 + (lane >> 4), ch = lane & 15; const size_t tr = (size_t)b * 2048 + q0w + row;
            const v4u o = *(const LAS v4u*)(wbuf + row * 272 + ch * 16);
            *(v4u*)(AA + tr * 2048 + hh * 128 + ch * 8) = gate_silu8(o, gg[it]); }
    }
}

constexpr int MM_K = 0, MM_VT = 17408;
__device__ __forceinline__ void mem_item(const Params& p, LAS unsigned char* lds, const int item, const int layer) {
    int tid_l = threadIdx.x; asm volatile("" : "+v"(tid_l));
    const int tid = tid_l, lane = tid & 63, wave = tid >> 6, r = lane & 31, h = lane >> 5;
    const int b = item >> 5, hh = (item >> 3) & 3, qb = item & 7;
    const bf16* Z = (const bf16*)(p.ws + WS_Z); bf16* AM = (bf16*)(p.ws + WS_AA);
    const bf16* MKV = (const bf16*)(p.ws + WS_MEMK) + (size_t)layer * 2048 * 1024;
    const size_t tq = (size_t)b * 2048 + qb * 256 + wave * 32 + r;
    v8s Q[1][8];
#pragma unroll
    for (int ks = 0; ks < 8; ++ks) Q[0][ks] = *(const v8s*)(Z + (size_t)T * OFF_MQ + tq * 512 + hh * 128 + ks * 16 + h * 8);
    AttnAcc<1> st; attn_init<1>(st);
    const int rowK = tid >> 4, ccK = tid & 15;
    const bf16* sK = MKV + ((size_t)b * 256 + rowK) * 1024 + hh * 128 + ccK * 8;
    LAS unsigned char* dK = lds + MM_K + rowK * 272 + ccK * 16; LAS unsigned char* dV = lds + MM_VT + rowK * 320 + ccK * 16;
    v4u g0 = *(const v4u*)sK, g1 = *(const v4u*)(sK + 32 * 1024), g2 = *(const v4u*)(sK + 512), g3 = *(const v4u*)(sK + 32 * 1024 + 512);
    const float c1 = 0.08838834764831845f * LOG2E;
    const BiasConst bf{0.f};
    for (int t = 0; t < 4; ++t) {
        __syncthreads();
        *(LAS v4u*)dK = g0; *(LAS v4u*)(dK + 32 * 272) = g1; *(LAS v4u*)dV = g2; *(LAS v4u*)(dV + 32 * 320) = g3;
        __syncthreads();
        if (t + 1 < 4) { const bf16* nK = sK + (size_t)(t + 1) * 64 * 1024;
            g0 = *(const v4u*)nK; g1 = *(const v4u*)(nK + 32 * 1024); g2 = *(const v4u*)(nK + 512); g3 = *(const v4u*)(nK + 32 * 1024 + 512); }
#pragma unroll
        for (int kk = 0; kk < 2; ++kk) attn_subtile<128, 1, 272, 320, false>(lds + MM_K, lds + MM_K, lds + MM_VT, kk, Q, nullptr, st, c1, bf, r, h);
    }
    const float l0 = st.l[0] + __shfl_xor(st.l[0], 32), i0 = 1.f / l0;
    LAS unsigned char* wbuf = lds + STG_OFF + wave * STG_WAVE;
    stg_write(wbuf, st.O[0], i0, r, h);
    v4u gg[8];
#pragma unroll
    for (int it = 0; it < 8; ++it) { const int row = it * 4 + (lane >> 4), ch = lane & 15; const size_t tr = (size_t)b * 2048 + qb * 256 + wave * 32 + row;
        gg[it] = *(const v4u*)(Z + (size_t)T * OFF_MG + tr * 512 + hh * 128 + ch * 8); }
#pragma unroll
    for (int it = 0; it < 8; ++it) { const int row = it * 4 + (lane >> 4), ch = lane & 15; const size_t tr = (size_t)b * 2048 + qb * 256 + wave * 32 + row;
        const v4u o = *(const LAS v4u*)(wbuf + row * 272 + ch * 16);
        *(v4u*)(AM + tr * 2048 + 1536 + hh * 128 + ch * 8) = gate_silu8(o, gg[it]); }
}

constexpr int DL_SUB = 37888, DL_K = 0, DL_VT = 17408, DL_TAB = 75776;
__device__ __forceinline__ void dil_item(const Params& p, LAS unsigned char* lds, const int bitem) {
    int tid_l = threadIdx.x; asm volatile("" : "+v"(tid_l));
    const int tid = tid_l, lane = tid & 63, wave = tid >> 6, r = lane & 31, h = lane >> 5, sub = wave >> 2, wq = wave & 3, ht = tid & 255;
    const int sid = 2 * bitem + sub, g = sid >> 9, rem = sid & 511;
    const int sh = 2 * g, dil = 1 << sh, L = 2048 >> sh, nI = L >> 7;
    const int ii = rem % nI, cls = (rem / nI) & (dil - 1), hh = (rem >> 4) & 3, b = rem >> 6;
    const bf16* Z = (const bf16*)(p.ws + WS_Z);
    bf16* OG = (bf16*)(p.ws + WS_OG) + (size_t)g * T * 512; float* LSE = (float*)(p.ws + WS_LSE) + (size_t)g * T * 4;
    const float* gtab = (const float*)(p.ws + WS_TAB) + 65536 + (g * 4 + hh) * 132;
    LAS unsigned char* base = lds + sub * DL_SUB;
    LAS float* tab = (LAS float*)(lds + DL_TAB) + sub * 132;
    const int jq0 = 128 * ii + 32 * wq, jq = jq0 + r;
    const size_t tq = (size_t)b * 2048 + (size_t)jq * dil + cls;
    __syncthreads();
    if (ht < 129) tab[ht] = gtab[ht];
    v8s Q[1][8];
#pragma unroll
    for (int ks = 0; ks < 8; ++ks) Q[0][ks] = *(const v8s*)(Z + (size_t)T * OFF_LQ + tq * 1536 + g * 512 + hh * 128 + ks * 16 + h * 8);
    AttnAcc<1> st; attn_init<1>(st);
    const int rowK = ht >> 4, ccK = ht & 15;
    const bf16* sKb = Z + (size_t)T * OFF_LK + ((size_t)b * 2048 + cls) * 1536 + g * 512 + hh * 128 + ccK * 8;
    LAS unsigned char* dK = base + DL_K + rowK * 272 + ccK * 16; LAS unsigned char* dV = base + DL_VT + rowK * 320 + ccK * 16;
    const int jbase = 128 * ii - 64;
    const float c1 = 0.08838834764831845f * LOG2E;
    v4u gk[4], gv[4];
#define DL_LOAD(j0_) do { if ((j0_) >= 0 && (j0_) < L) { _Pragma("unroll") for (int i = 0; i < 4; ++i) { const bf16* sp = sKb + (size_t)((j0_) + rowK + 16 * i) * dil * 1536; gk[i] = *(const v4u*)sp; gv[i] = *(const v4u*)(sp + (size_t)T * (OFF_LV - OFF_LK)); } } } while (0)
    DL_LOAD(jbase);
#pragma unroll 1
    for (int t = 0; t < 4; ++t) {
        const int j0 = jbase + 64 * t; const bool act = (j0 >= 0 && j0 < L);
        __syncthreads();
        if (act) {
#pragma unroll
            for (int i = 0; i < 4; ++i) { *(LAS v4u*)(dK + 16 * i * 272) = gk[i]; *(LAS v4u*)(dV + 16 * i * 320) = gv[i]; } }
        __syncthreads();
        if (t + 1 < 4) DL_LOAD(j0 + 64);
        if (act) {
#pragma unroll
            for (int kk = 0; kk < 2; ++kk) {
                const int js = j0 + 32 * kk;
                if (js + 31 >= jq0 - 64 && js <= jq0 + 31 + 64) {
                    const BiasBand bf{tab, js + 4 * h - jq};
                    attn_subtile<128, 1, 272, 320, false>(base + DL_K, base + DL_K, base + DL_VT, kk, Q, nullptr, st, c1, bf, r, h);
                }
            }
        }
    }
    const float l0 = st.l[0] + __shfl_xor(st.l[0], 32), i0 = 1.f / l0;
    LAS unsigned char* wbuf = lds + STG_OFF + wave * STG_WAVE;
    stg_write(wbuf, st.O[0], i0, r, h);
#pragma unroll
    for (int it = 0; it < 8; ++it) { const int row = it * 4 + (lane >> 4), ch = lane & 15; const size_t tr = (size_t)b * 2048 + (size_t)(jq0 + row) * dil + cls;
        *(v4u*)(OG + tr * 512 + hh * 128 + ch * 8) = *(const LAS v4u*)(wbuf + row * 272 + ch * 16); }
    if (h == 0) LSE[tq * 4 + hh] = st.m[0] * LN2 + __logf(l0);
}

__device__ __forceinline__ void dil_combine_rows4(const Params& p, const int t0, const int stride, const int lane) {
    const bf16* Z = (const bf16*)(p.ws + WS_Z); const bf16* OG = (const bf16*)(p.ws + WS_OG); const float* LSE = (const float*)(p.ws + WS_LSE); bf16* AB = (bf16*)(p.ws + WS_AA);
    const int hh = lane >> 4;
    float a0[4], a1[4], a2[4]; v4u o0[4], o1[4], o2[4], gg[4];
#pragma unroll
    for (int k = 0; k < 4; ++k) { const size_t t = (size_t)t0 + (size_t)k * stride;
        a0[k] = LSE[t * 4 + hh]; a1[k] = LSE[((size_t)T + t) * 4 + hh]; a2[k] = LSE[((size_t)2 * T + t) * 4 + hh];
        o0[k] = *(const v4u*)(OG + t * 512 + 8 * lane); o1[k] = *(const v4u*)(OG + ((size_t)T + t) * 512 + 8 * lane); o2[k] = *(const v4u*)(OG + ((size_t)2 * T + t) * 512 + 8 * lane);
        gg[k] = *(const v4u*)(Z + (size_t)T * OFF_LG + t * 512 + 8 * lane); }
#pragma unroll
    for (int k = 0; k < 4; ++k) { const size_t t = (size_t)t0 + (size_t)k * stride;
        const float mx = fmaxf(a0[k], fmaxf(a1[k], a2[k]));
        float w0 = __expf(a0[k] - mx), w1 = __expf(a1[k] - mx), w2 = __expf(a2[k] - mx); const float inv = 1.f / (w0 + w1 + w2); w0 *= inv; w1 *= inv; w2 *= inv;
        v4u o;
#define CMB(c) pk2((w0 * bflo(o0[k].c) + w1 * bflo(o1[k].c) + w2 * bflo(o2[k].c)) * silu_f(bflo(gg[k].c)), (w0 * bfhi(o0[k].c) + w1 * bfhi(o1[k].c) + w2 * bfhi(o2[k].c)) * silu_f(bfhi(gg[k].c)))
        o.x = CMB(x); o.y = CMB(y); o.z = CMB(z); o.w = CMB(w);
#undef CMB
        *(v4u*)(AB + t * 2048 + 1024 + 8 * lane) = o; }
}
__device__ __forceinline__ void rms_rows4_bf16(const float* x, const float* g, bf16* out, const int m0, const int stride, const int lane) {
    v4f v[4][4]; float ss[4];
#pragma unroll
    for (int k = 0; k < 4; ++k) { const v4f* xr = (const v4f*)(x + ((size_t)m0 + (size_t)k * stride) * 1024) + lane; float s = 0.f;
#pragma unroll
        for (int j = 0; j < 4; ++j) { v[k][j] = xr[64 * j]; s += (v[k][j].x * v[k][j].x + v[k][j].y * v[k][j].y) + (v[k][j].z * v[k][j].z + v[k][j].w * v[k][j].w); }
        ss[k] = s; }
    const v4f* gr = (const v4f*)g + lane; v4f gv[4];
#pragma unroll
    for (int j = 0; j < 4; ++j) gv[j] = gr[64 * j];
#pragma unroll
    for (int k = 0; k < 4; ++k) { const float rstd = rsqrtf(wave_sum(ss[k]) * (1.f / 1024.f) + EPS);
        v2u* o8 = (v2u*)(out + ((size_t)m0 + (size_t)k * stride) * 1024) + lane;
#pragma unroll
        for (int j = 0; j < 4; ++j) { v2u o; o.x = pk2(v[k][j].x * rstd * gv[j].x, v[k][j].y * rstd * gv[j].y); o.y = pk2(v[k][j].z * rstd * gv[j].z, v[k][j].w * rstd * gv[j].w); o8[64 * j] = o; } }
}
__device__ __forceinline__ void rms_rows4_f32(const float* x, const float* g, float* out, const int m0, const int stride, const int lane) {
    v4f v[4][4]; float ss[4];
#pragma unroll
    for (int k = 0; k < 4; ++k) { const v4f* xr = (const v4f*)(x + ((size_t)m0 + (size_t)k * stride) * 1024) + lane; float s = 0.f;
#pragma unroll
        for (int j = 0; j < 4; ++j) { v[k][j] = xr[64 * j]; s += (v[k][j].x * v[k][j].x + v[k][j].y * v[k][j].y) + (v[k][j].z * v[k][j].z + v[k][j].w * v[k][j].w); }
        ss[k] = s; }
    const v4f* gr = (const v4f*)g + lane; v4f gv[4];
#pragma unroll
    for (int j = 0; j < 4; ++j) gv[j] = gr[64 * j];
#pragma unroll
    for (int k = 0; k < 4; ++k) { const float rstd = rsqrtf(wave_sum(ss[k]) * (1.f / 1024.f) + EPS);
        v4f* o = (v4f*)(out + ((size_t)m0 + (size_t)k * stride) * 1024) + lane;
#pragma unroll
        for (int j = 0; j < 4; ++j) o[64 * j] = v[k][j] * rstd * gv[j]; }
}
#define XB_TMO      128
#define XB_XCNT(j)  (256  + 64 * (j))
#define XB_XSUB(j)  (1280 + 64 * (j))
#define XB_XGEN(j)  (2304 + 64 * (j))
#define XB_TOP      3328
#define XB_TOPGEN   3392
#define XCD_BAR_WORDS 3456
#define XB_SPIN_CAP (1u << 18)

__device__ __forceinline__ unsigned xb_ld(unsigned* p)              { return __hip_atomic_load(p, __ATOMIC_RELAXED, __HIP_MEMORY_SCOPE_AGENT); }
__device__ __forceinline__ unsigned xb_add(unsigned* p, unsigned v) { return __hip_atomic_fetch_add(p, v, __ATOMIC_RELAXED, __HIP_MEMORY_SCOPE_AGENT); }
__device__ __forceinline__ unsigned xb_xcc_id() { return (unsigned)__builtin_amdgcn_s_getreg((3 << 11) | 20) & 0xFu; }
#define XB_SPIN(cond, bar) do { unsigned _sp = 0; while (cond) { __builtin_amdgcn_s_sleep(1); \
    if ((++_sp & 255u) == 0u) { if (xb_ld(&(bar)[XB_TMO])) break; if (_sp > XB_SPIN_CAP) { atomicAdd(&(bar)[XB_TMO], 1u); break; } } } } while (0)

struct XcdBarrier {
    unsigned* bar; unsigned x;
    volatile LAS unsigned* st;
};

__device__ __forceinline__ XcdBarrier xcd_barrier_post(unsigned* bar, volatile LAS unsigned* st) {
    XcdBarrier b; b.bar = bar; b.x = xb_xcc_id(); b.st = st;
    if (threadIdx.x == 0) (void)xb_add(&bar[XB_XCNT(b.x)], 1u);
    return b;
}
__device__ __forceinline__ void xcd_barrier_complete(unsigned* bar, unsigned x, unsigned& nloc, unsigned& nx) {
    const unsigned G = gridDim.x * gridDim.y * gridDim.z;
    unsigned sum, cnt, mine, sp = 0u;
    for (;;) {
        sum = 0u; cnt = 0u; mine = 0u;
#pragma unroll
        for (unsigned j = 0; j < 16; ++j) { const unsigned c = xb_ld(&bar[XB_XCNT(j)]); sum += c; cnt += (c > 0u) ? 1u : 0u; mine = (j == x) ? c : mine; }
        if (sum == G) break;
        __builtin_amdgcn_s_sleep(1);
        if ((++sp & 255u) == 0u) { if (xb_ld(&bar[XB_TMO])) break; if (sp > XB_SPIN_CAP) { atomicAdd(&bar[XB_TMO], 1u); break; } }
    }
    nloc = mine > 0u ? mine : 1u; nx = cnt > 0u ? cnt : 1u;
}

__device__ __forceinline__ void xcd_barrier(const XcdBarrier& b) {
    asm volatile("s_waitcnt vmcnt(0)" ::: "memory");
    __syncthreads();
    if (threadIdx.x == 0) {
        unsigned* bar = b.bar;
        __builtin_amdgcn_s_waitcnt(0);
        unsigned nloc = b.st[0], nx = b.st[1];
        if (nloc == 0u) { xcd_barrier_complete(bar, b.x, nloc, nx); b.st[0] = nloc; b.st[1] = nx; }
        const unsigned old = xb_add(&bar[XB_XSUB(b.x)], 1u);
        const unsigned gen = old / nloc;
        if (old + 1u == (gen + 1u) * nloc) {
            __builtin_amdgcn_fence(__ATOMIC_RELEASE, "agent");
            asm volatile("s_waitcnt vmcnt(0)" ::: "memory");
            const unsigned og = xb_add(&bar[XB_TOP], 1u);
            const unsigned tg = og / nx;
            if (og + 1u == (tg + 1u) * nx) xb_add(&bar[XB_TOPGEN], 1u);
            else XB_SPIN(xb_ld(&bar[XB_TOPGEN]) == tg, bar);
            __builtin_amdgcn_fence(__ATOMIC_ACQUIRE, "agent");
            xb_add(&bar[XB_XGEN(b.x)], 1u);
            asm volatile("s_waitcnt vmcnt(0)" ::: "memory");
        } else {
            XB_SPIN(xb_ld(&bar[XB_XGEN(b.x)]) == gen, bar);
            __builtin_amdgcn_fence(__ATOMIC_ACQUIRE, "agent");
            asm volatile("s_waitcnt vmcnt(0)" ::: "memory");
        }
    }
    __syncthreads();
}

__global__ void __launch_bounds__(512, 2) mega_fwd(Params p) {
    extern __shared__ __attribute__((aligned(16))) unsigned char lds_raw[];
    cg::grid_group grid = cg::this_grid();
    LAS unsigned char* lds = (LAS unsigned char*)lds_raw;
    const int tid = threadIdx.x, lane = tid & 63, wave = __builtin_amdgcn_readfirstlane(tid >> 6);
    const int G = gridDim.x, bid = blockIdx.x;
    const int gw = bid * 8 + wave, NGW = G * 8;
    unsigned char* ws = p.ws;
    bf16* Zb = (bf16*)(ws + WS_Z); bf16* Hb = (bf16*)(ws + WS_H);
    if (tid < 16) ((LAS unsigned*)(lds + LDS_MISC))[tid] = 0u;
    __syncthreads();
    const XcdBarrier xbar = xcd_barrier_post((unsigned*)(ws + WS_BAR), (volatile LAS unsigned*)(lds + LDS_MISC));

#pragma unroll 1
    for (int rep = 0; rep < PROBE_DUP_P0; ++rep) {
        LAS float* scr = (LAS float*)(lds + wave * 16384);
        constexpr int I_IN = 16 * 416, I_MKV = 16 * 32, I_BD = 16 * 32, I_BL = 8 * 32, I_BM = 8 * 32, I_OUT = 16 * 32, I_LAYER = I_IN + I_MKV + I_BD + I_BL + I_BM + I_OUT;
        for (int it = gw; it < DEPTH * I_LAYER; it += NGW) {
            const int l = it / I_LAYER; int r = it % I_LAYER;
            if (r < I_IN) { p0_transpose_item(p.w_in + (size_t)l * 1024 * NIN, 1024, NIN, (bf16*)(ws + WS_WIN) + (size_t)l * NIN * 1024, 1024, scr, r, lane); continue; } r -= I_IN;
            if (r < I_MKV) { p0_transpose_item(p.w_mem_kv + (size_t)l * 1024 * 1024, 1024, 1024, (bf16*)(ws + WS_WMKV) + (size_t)l * 1024 * 1024, 1024, scr, r, lane); continue; } r -= I_MKV;
            if (r < I_BD) { p0_transpose_item(p.w_br_diff + (size_t)l * 1024 * 1024, 1024, 1024, (bf16*)(ws + WS_WBD) + (size_t)l * 1024 * 2048, 2048, scr, r, lane); continue; } r -= I_BD;
            if (r < I_BL) { p0_transpose_item(p.w_br_dil + (size_t)l * 512 * 1024, 512, 1024, (bf16*)(ws + WS_WBD) + (size_t)l * 1024 * 2048 + 1024, 2048, scr, r, lane); continue; } r -= I_BL;
            if (r < I_BM) { p0_transpose_item(p.w_br_mem + (size_t)l * 512 * 1024, 512, 1024, (bf16*)(ws + WS_WBD) + (size_t)l * 1024 * 2048 + 1536, 2048, scr, r, lane); continue; } r -= I_BM;
            p0_transpose_item(p.w_out + (size_t)l * 1024 * 1024, 1024, 1024, (bf16*)(ws + WS_WOUT) + (size_t)l * 1024 * 1024, 1024, scr, r, lane);
        }
        for (int m = gw; m + 3 * NGW < T; m += 4 * NGW) rms_rows4_bf16(p.x, p.g_norm, Hb, m, NGW, lane);
        for (int m = gw; m < DEPTH * 2048; m += NGW) { const int l = m >> 11, row = m & 2047;
            rms_row_bf16(p.mem + (size_t)row * 1024, p.g_mem + l * 1024, (bf16*)(ws + WS_MEMN) + (size_t)m * 1024, lane); }
        float* dtab = (float*)(ws + WS_TAB);
        for (int i = bid * 512 + tid; i < 8 * 4096; i += G * 512) { const int hh = i >> 12, idx = i & 4095; if (idx < 4095) dtab[i] = p.rel_bias[t5_bucket(idx - 2047) * 20 + hh] * LOG2E; }
        for (int i = bid * 512 + tid; i < 12 * 132; i += G * 512) { const int gh = i / 132, d = i % 132; if (d < 129) { const int g = gh >> 2; dtab[65536 + i] = p.rel_bias[t5_bucket((d - 64) * (1 << (2 * g))) * 20 + 8 + gh] * LOG2E; } }
    }
    grid.sync();

#pragma unroll 1
    for (int l = 0; l < DEPTH; ++l) {
        int lane_i = tid & 63; asm volatile("" : "+v"(lane_i));
#ifndef SKIP_MKV
        if (l == 0) {
#pragma unroll 1
            for (int ll = 0; ll < DEPTH; ++ll) {
                pg8::Gemm g{(const pg8::bf16_t*)(ws + WS_MEMN) + (size_t)ll * 2048 * 1024, (const pg8::bf16_t*)(ws + WS_WMKV) + (size_t)ll * 1024 * 1024, 2048, 1024, 1024};
                pg8::StaticOrder S; S.init(2048, 1024, G, (bid + 32 * ll) % G);
                EpiInT<false> E{(bf16*)(ws + WS_MEMK) + (size_t)ll * 2048 * 1024, 1024};
                pg8::gemm_phase<EpiInT<false>, pg8::StaticOrder>(lds, g, S, E);
            }
        }
#endif
#ifndef SKIP_IN
#pragma unroll 1
        for (int rep = 0; rep < PROBE_DUP_IN; ++rep) {
            pg8::Gemm g{(const pg8::bf16_t*)Hb, (const pg8::bf16_t*)(ws + WS_WIN) + (size_t)l * NIN * 1024, T, NIN, 1024};
            pg8::StaticOrder S; S.init(T, NIN, G, bid);
            EpiInT<true> E{Zb, NIN};
            pg8::gemm_phase<EpiInT<true>, pg8::StaticOrder>(lds, g, S, E);
        }
#endif
        GSYNC();
#ifndef SKIP_B1
        for (int rep = 0; rep < PROBE_DUP_B1; ++rep)
        for (int it = bid; it < 256 + 768; it += G) { if (it < 256) mem_item(p, lds, it, l); else dil_item(p, lds, it - 256); }
#endif
        GSYNC();
        {
            const float* lp = p.diff_lambda + l * 256;
            const float lam_init = 0.8f - 0.6f * expf(-0.3f * (float)l);
            const float lam = expf(wave_sum(lp[lane_i] * lp[64 + lane_i])) - expf(wave_sum(lp[128 + lane_i] * lp[192 + lane_i])) + lam_init;
#ifndef SKIP_DIFF
            for (int rep = 0; rep < PROBE_DUP_DIFF; ++rep)
            if (G == 256) {
                const int x = bid & 7, j = bid >> 3;
                for (int i = 0; i < 4; ++i) diff2_item(p, lds, (x + 8 * (2 * i + (j >> 4))) * 16 + (j & 15), lam, lam_init);
            } else
            for (int it = bid; it < 1024; it += G) diff2_item(p, lds, it, lam, lam_init);
#endif
            for (int t = gw; t + 3 * NGW < T; t += 4 * NGW) dil_combine_rows4(p, t, NGW, lane_i);
        }
        GSYNC();
#ifndef SKIP_PC
#pragma unroll 1
        for (int rep = 0; rep < PROBE_DUP_PC; ++rep) {
            pg8::StaticOrder S; S.init(T, 1024, G, bid);
            pg8::Gemm g{(const pg8::bf16_t*)(ws + WS_AA), (const pg8::bf16_t*)(ws + WS_WBD) + (size_t)l * 1024 * 2048, T, 1024, 512};
            EpiMergeChain E{Zb, (bf16*)(ws + WS_MERGED_BF)};
            ChainOrder CS; CS.S = S;
            pg8::gemm_phase<EpiMergeChain, ChainOrder>(lds, g, CS, E);
        }
#endif
        GSYNC();
#ifndef SKIP_PD
        {
            pg8::Gemm g{(const pg8::bf16_t*)(ws + WS_MERGED_BF), (const pg8::bf16_t*)(ws + WS_WOUT) + (size_t)l * 1024 * 1024, T, 1024, 1024};
            pg8::StaticOrder S; S.init(T, 1024, G, bid);
            EpiOut E{l == 0 ? p.x : (const float*)p.out, p.out};
            pg8::gemm_phase<EpiOut, pg8::StaticOrder>(lds, g, S, E);
        }
#endif
        GSYNC();
        if (l + 1 < DEPTH) { for (int m = gw; m + 3 * NGW < T; m += 4 * NGW) rms_rows4_bf16(p.out, p.g_norm + (l + 1) * 1024, Hb, m, NGW, lane_i); GSYNC(); }
        else { for (int m = gw; m + 3 * NGW < T; m += 4 * NGW) rms_rows4_f32(p.out, p.g_final, p.out, m, NGW, lane_i); }
    }
}

extern "C" void kernel_launch(void* const* d_in, const int* in_sizes, int n_in, void* d_out, int out_size, void* d_ws, size_t ws_size, hipStream_t stream) {
    static int grid = 0;
    if (grid == 0) {
        if (n_in != 13 || out_size != T * DM || ws_size < WS_END) { fprintf(stderr, "kernel_launch: unexpected shapes (n_in %d out %d ws %zu, need %zu)\n", n_in, out_size, ws_size, (size_t)WS_END); grid = -1; return; }
        int dev = 0, cus = 0, per_cu = 0;
        (void)hipGetDevice(&dev); (void)hipDeviceGetAttribute(&cus, hipDeviceAttributeMultiprocessorCount, dev);
        if (hipFuncSetAttribute((const void*)mega_fwd, hipFuncAttributeMaxDynamicSharedMemorySize, LDS_BYTES) != hipSuccess) { fprintf(stderr, "kernel_launch: hipFuncSetAttribute failed\n"); grid = -1; return; }
        if (hipOccupancyMaxActiveBlocksPerMultiprocessor(&per_cu, (const void*)mega_fwd, 512, LDS_BYTES) != hipSuccess || per_cu < 1) { fprintf(stderr, "kernel_launch: occupancy query says %d\n", per_cu); per_cu = 1; }
        (void)hipGetLastError();
        grid = cus * 1;
        if (grid > 256) grid = 256;
    }
    if (grid < 0) return;
    Params p{};
    p.x = (const float*)d_in[0]; p.mem = (const float*)d_in[1]; p.g_norm = (const float*)d_in[2]; p.w_in = (const float*)d_in[3]; p.diff_lambda = (const float*)d_in[4];
    p.w_mem_kv = (const float*)d_in[5]; p.g_mem = (const float*)d_in[6]; p.w_br_diff = (const float*)d_in[7]; p.w_br_dil = (const float*)d_in[8]; p.w_br_mem = (const float*)d_in[9];
    p.w_out = (const float*)d_in[10]; p.rel_bias = (const float*)d_in[11]; p.g_final = (const float*)d_in[12];
    p.out = (float*)d_out; p.ws = (unsigned char*)d_ws;
    if (hipMemsetAsync((unsigned char*)d_ws + WS_BAR, 0, XCD_BAR_WORDS * 4, stream) != hipSuccess) { fprintf(stderr, "kernel_launch: memset failed\n"); return; }
    void* args[] = {&p};
    hipError_t e = hipLaunchCooperativeKernel((const void*)mega_fwd, dim3(grid), dim3(512), args, LDS_BYTES, stream);
    if (e != hipSuccess) fprintf(stderr, "cooperative launch failed: %s (grid %d)\n", hipGetErrorString(e), grid);
}
```

```cpp
#include <hip/hip_runtime.h>
#include <hip/hip_cooperative_groups.h>
#include <cstdio>
#include <cstdint>
namespace cg = cooperative_groups;
#define PROBE_DUP_DIFF 1
#define PROBE_DUP_IN 1
#define PROBE_DUP_SYNC 1
#define PROBE_DUP_P0 1
#define PROBE_DUP_B1 1
#define PROBE_DUP_PC 1
#define GSYNC() do { for (int rep_ = 0; rep_ < PROBE_DUP_SYNC; ++rep_) xcd_barrier(xbar); } while (0)

namespace pg8 {
#define PG8_LAS __attribute__((address_space(3)))
typedef unsigned short bf16_t;
typedef short bf16x8 __attribute__((ext_vector_type(8)));
typedef float f32x4 __attribute__((ext_vector_type(4)));
typedef unsigned u32x4 __attribute__((ext_vector_type(4)));
constexpr int BM = 256, BK = 64, HALF = 128, HTB = HALF * BK * 2  , STAGE_BYTES = 8 * HTB, NXCD = 8, WGM = 4;

__host__ __device__ __forceinline__ int lds_byte(int r, int c) { const int st = (r >> 4) * 2 + (c >> 5), rr = r & 15, cc = c & 31, ob = rr * 64 + cc * 2; return st * 1024 + (ob ^ (((ob >> 9) & 1) << 5)); }
__host__ __device__ __forceinline__ void stage_rc(int b, int& R, int& C) { const int st = b / 1024, sb = b % 1024, swz = sb ^ (((sb >> 9) & 1) << 5); R = (st >> 1) * 16 + swz / 64; C = (st & 1) * 32 + (swz % 64) / 2; }
__host__ __device__ __forceinline__ int perm32(int rho) { const int n = rho >> 4, i = rho & 15; return 8 * (i >> 2) + 4 * n + (i & 3); }

struct Unit { int pm, pn, seg; };
struct Gemm { const bf16_t* A; const bf16_t* Bt; int M, N, K; };

struct StaticOrder {
    int nM, nN, nwg, G, c;
    __host__ __device__ void init(int M, int N, int G_, int c_) { nM = M / BM; nN = N / BM; nwg = nM * nN; G = G_; c = c_; }
    __host__ __device__ bool next(int i, Unit& u) const {
        const long L = (long)i * G + c; if (L >= nwg) return false;
        int wgid = (int)L; { const int q = nwg / NXCD, r = nwg % NXCD, xcd = wgid % NXCD, off = wgid / NXCD; wgid = (xcd < r ? xcd * (q + 1) : r * (q + 1) + (xcd - r) * q) + off; }
        const int nig = WGM * nN, gid = wgid / nig, fm = gid * WGM, gsz = (nM - fm) < WGM ? (nM - fm) : WGM;
        u.pm = fm + ((wgid % nig) % gsz); u.pn = (wgid % nig) / gsz; u.seg = 0; return true;
    }
    __device__ __forceinline__ void a_ready(const Unit&) const {}
    __device__ __forceinline__ void done(const Unit&) const {}
};
template <class Epi, class Sched>
__device__ __forceinline__ void gemm_phase(PG8_LAS unsigned char* lds, const Gemm g, const Sched& S, const Epi& E) {
    int tid_l = threadIdx.x; asm volatile("" : "+v"(tid_l));
    const int tid = tid_l, wid = __builtin_amdgcn_readfirstlane(tid >> 6), lane = tid & 63, wr = wid >> 2, wc = wid & 3, fr = lane & 15, fq = lane >> 4;
    const int K = g.K, nt = K / BK;
    const int LD = Epi::KEEP_ACC ? 2048 : K; constexpr int SEGB = Epi::KEEP_ACC ? 1024 : 0;
    unsigned voffA[2], voffB[2];
#pragma unroll
    for (int i = 0; i < 2; ++i) { int R, C; stage_rc(tid * 16 + i * 8192, R, C); const int Rb = Epi::PERM ? ((R & ~31) + perm32(R & 31)) : R;
        voffA[i] = (unsigned)(R * LD + C) * 2u; voffB[i] = (unsigned)(Rb * LD + C) * 2u; }
    const size_t kstep = (size_t)(BK * 2);
    const size_t hstep = (size_t)HALF * LD * 2;
    const size_t tstep = 2 * hstep;
    const unsigned ldsw = (unsigned)wid * 1024u;
    const int aoff = lds_byte(wr * 64 + fr, fq * 8), boff = lds_byte(wc * 32 + fr, fq * 8);
#define PG8_SA(b, h) (((b) * 2 + (h)) * HTB)
#define PG8_SB(b, h) ((4 + (b) * 2 + (h)) * HTB)
#define PG8_STAGE(bufoff, gbase, voff) do { _Pragma("unroll") for (int _i = 0; _i < 2; ++_i) \
        __builtin_amdgcn_global_load_lds((const unsigned*)((const char*)(gbase) + (voff)[_i]), (PG8_LAS unsigned*)(lds + (bufoff) + ldsw + _i * 8192), 16, 0, 0); } while (0)
#define PG8_LDA(dst, b, h) do { _Pragma("unroll") for (int m = 0; m < 4; ++m) _Pragma("unroll") for (int k = 0; k < 2; ++k) dst[m][k] = *(const PG8_LAS bf16x8*)(lds + PG8_SA(b, h) + aoff + m * 2048 + k * 1024); } while (0)
#define PG8_LDB(dst, b, h) do { _Pragma("unroll") for (int n = 0; n < 2; ++n) _Pragma("unroll") for (int k = 0; k < 2; ++k) dst[n][k] = *(const PG8_LAS bf16x8*)(lds + PG8_SB(b, h) + boff + n * 2048 + k * 1024); } while (0)
#define PG8_MMA(ai, bj, At, Bt) do { __builtin_amdgcn_s_setprio(1); _Pragma("unroll") for (int m = 0; m < 4; ++m) _Pragma("unroll") for (int n = 0; n < 2; ++n) _Pragma("unroll") for (int k = 0; k < 2; ++k) \
        acc[ai][bj][m][n] = __builtin_amdgcn_mfma_f32_16x16x32_bf16(Bt[n][k], At[m][k], acc[ai][bj][m][n], 0, 0, 0); __builtin_amdgcn_s_setprio(0); } while (0)
#define PG8_WAIT_V(n) asm volatile("s_waitcnt vmcnt(" #n ")" ::: "memory")
#define PG8_WAIT_L(n) asm volatile("s_waitcnt lgkmcnt(" #n ")" ::: "memory")
#define PG8_BAR __builtin_amdgcn_s_barrier()
#define PG8_SCHED __builtin_amdgcn_sched_barrier(0)
    Unit cur, nxt; int ui = 0;
    if (!S.next(0, cur)) return;
    f32x4 acc[2][2][4][2];
#pragma unroll
    for (int a = 0; a < 2; ++a)
#pragma unroll
        for (int b = 0; b < 2; ++b)
#pragma unroll
            for (int m = 0; m < 4; ++m)
#pragma unroll
                for (int n = 0; n < 2; ++n) acc[a][b][m][n] = (f32x4){0.f, 0.f, 0.f, 0.f};
    if constexpr (Epi::HAS_INIT) E.init(acc, cur, wr, wc, fr, fq);
    bf16x8 At[4][2], B0[2][2], B1[2][2];
    const char* cA = (const char*)g.A + (size_t)cur.pm * tstep + (size_t)cur.seg * SEGB; const char* cB = (const char*)g.Bt + (size_t)cur.pn * tstep + (size_t)cur.seg * SEGB;
    S.a_ready(cur);
    PG8_STAGE(PG8_SB(0, 0), cB, voffB); PG8_STAGE(PG8_SA(0, 0), cA, voffA); PG8_STAGE(PG8_SB(0, 1), cB + hstep, voffB); PG8_STAGE(PG8_SA(0, 1), cA + hstep, voffA);
    if (wr == 1) PG8_BAR;
    PG8_WAIT_V(4); PG8_BAR;
    PG8_STAGE(PG8_SB(1, 0), cB + kstep, voffB); PG8_STAGE(PG8_SA(1, 0), cA + kstep, voffA); PG8_STAGE(PG8_SB(1, 1), cB + hstep + kstep, voffB);
    PG8_WAIT_V(6); PG8_BAR;
    for (;;) {
        const bool has_next = S.next(ui + 1, nxt);
        const char* nA = has_next ? (const char*)g.A + (size_t)nxt.pm * tstep + (size_t)nxt.seg * SEGB : cA; const char* nB = has_next ? (const char*)g.Bt + (size_t)nxt.pn * tstep + (size_t)nxt.seg * SEGB : cB;
        for (int t = 0; t < nt; t += 2) {
            const bool last = (t == nt - 2);
            const char* a1 = cA + (size_t)(t + 1) * kstep;
            const char* a2 = last ? nA : cA + (size_t)(t + 2) * kstep; const char* b2 = last ? nB : cB + (size_t)(t + 2) * kstep;
            const char* a3 = a2 + kstep; const char* b3 = b2 + kstep;
            if (last && has_next) S.a_ready(nxt);
            PG8_LDB(B0, 0, 0); PG8_SCHED; PG8_LDA(At, 0, 0); PG8_STAGE(PG8_SA(1, 1), a1 + hstep, voffA);
            PG8_WAIT_L(8); PG8_BAR; PG8_WAIT_L(0); PG8_MMA(0, 0, At, B0); PG8_BAR; PG8_SCHED;
            PG8_LDB(B1, 0, 1); PG8_STAGE(PG8_SB(0, 0), b2, voffB);
            PG8_BAR; PG8_WAIT_L(0); PG8_MMA(0, 1, At, B1); PG8_BAR;
            PG8_LDA(At, 0, 1); PG8_STAGE(PG8_SA(0, 0), a2, voffA);
            PG8_BAR; PG8_WAIT_L(0); PG8_MMA(1, 0, At, B0); PG8_BAR; PG8_SCHED;
            PG8_STAGE(PG8_SB(0, 1), b2 + hstep, voffB);
            PG8_WAIT_V(6); PG8_BAR; PG8_MMA(1, 1, At, B1); PG8_BAR;
            PG8_LDB(B0, 1, 0); PG8_SCHED; PG8_LDA(At, 1, 0); PG8_STAGE(PG8_SA(0, 1), a2 + hstep, voffA);
            PG8_WAIT_L(8); PG8_BAR; PG8_WAIT_L(0); PG8_MMA(0, 0, At, B0); PG8_BAR; PG8_SCHED;
            PG8_LDB(B1, 1, 1); PG8_STAGE(PG8_SB(1, 0), b3, voffB);
            PG8_BAR; PG8_WAIT_L(0); PG8_MMA(0, 1, At, B1); PG8_BAR;
            PG8_LDA(At, 1, 1); PG8_STAGE(PG8_SA(1, 0), a3, voffA);
            PG8_BAR; PG8_WAIT_L(0); PG8_MMA(1, 0, At, B0); PG8_BAR; PG8_SCHED;
            PG8_STAGE(PG8_SB(1, 1), b3 + hstep, voffB);
            PG8_WAIT_V(6); PG8_BAR; PG8_MMA(1, 1, At, B1); PG8_BAR;
        }
        if constexpr (!Epi::AFTER_DRAIN) { E(acc, cur, wr, wc, fr, fq); S.done(cur); }
        if (!has_next) break;
        if (!Epi::KEEP_ACC || cur.seg == 3)
#pragma unroll
        for (int a = 0; a < 2; ++a)
#pragma unroll
            for (int b = 0; b < 2; ++b)
#pragma unroll
                for (int m = 0; m < 4; ++m)
#pragma unroll
                    for (int n = 0; n < 2; ++n) acc[a][b][m][n] = (f32x4){0.f, 0.f, 0.f, 0.f};
        cur = nxt; cA = nA; cB = nB; ++ui;
        if constexpr (Epi::HAS_INIT) E.init(acc, cur, wr, wc, fr, fq);
    }
    PG8_WAIT_V(0);
    if (wr == 0) PG8_BAR;
    PG8_BAR;
    if constexpr (Epi::AFTER_DRAIN) { E.fused(acc, cur, wr, wc, fr, fq, lds, wid, lane); S.done(cur); }
#undef PG8_SA
#undef PG8_SB
#undef PG8_STAGE
#undef PG8_LDA
#undef PG8_LDB
#undef PG8_MMA
#undef PG8_WAIT_V
#undef PG8_WAIT_L
#undef PG8_BAR
#undef PG8_SCHED
}
}

#define LAS __attribute__((address_space(3)))
typedef unsigned short bf16;
typedef short v8s __attribute__((ext_vector_type(8)));
typedef short v4s __attribute__((ext_vector_type(4)));
typedef float v16f __attribute__((ext_vector_type(16)));
typedef float v4f __attribute__((ext_vector_type(4)));
typedef float v2f __attribute__((ext_vector_type(2)));
typedef unsigned v4u __attribute__((ext_vector_type(4)));
typedef unsigned v2u __attribute__((ext_vector_type(2)));
typedef __bf16 v2bf __attribute__((ext_vector_type(2)));

constexpr int NB = 8, SEQ = 2048, DM = 1024, T = NB * SEQ, DEPTH = 4, NMEM = 256, NIN = 13312;
constexpr int OFF_DQ = 0, OFF_DK = 1024, OFF_DV = 2048, OFF_DG = 3072, OFF_LQ = 4096, OFF_LK = 5632, OFF_LV = 7168, OFF_LG = 8704, OFF_MQ = 9216, OFF_MG = 9728, OFF_GATE = 10240;
constexpr float EPS = 1e-6f, LOG2E = 1.4426950408889634f, LN2 = 0.6931471805599453f, NEGBIG = -1e30f;

constexpr size_t MiB = 1u << 20;
constexpr size_t WS_WIN = 0;
constexpr size_t WS_WMKV = 104 * MiB;
constexpr size_t WS_WBD = 112 * MiB;
constexpr size_t WS_WBL = 120 * MiB;
constexpr size_t WS_WBM = 124 * MiB;
constexpr size_t WS_WOUT = 128 * MiB;
constexpr size_t WS_MEMN = 136 * MiB;
constexpr size_t WS_MEMK = 152 * MiB;
constexpr size_t WS_MEMVT = 160 * MiB;
constexpr size_t WS_TAB = 168 * MiB;
constexpr size_t WS_BAR = 168 * MiB + 768 * 1024;
constexpr size_t WS_H = 169 * MiB;
constexpr size_t WS_AA = 201 * MiB;
constexpr size_t WS_AB = 233 * MiB;
constexpr size_t WS_AM = 249 * MiB;
constexpr size_t WS_OG = 265 * MiB;
constexpr size_t WS_LSE = 313 * MiB;
constexpr size_t WS_DVT = 314 * MiB;
constexpr size_t WS_LVT = 346 * MiB;
constexpr size_t WS_Z = 394 * MiB;
constexpr size_t WS_END = 810 * MiB;
constexpr size_t WS_MERGED_F32 = WS_DVT;
constexpr size_t WS_MERGED_BF = WS_H;
static_assert(WS_Z + (size_t)T * NIN * 2 <= WS_END, "ws map");

constexpr int LDS_BYTES = 155648;
constexpr int LDS_MISC = 155392;

__device__ __forceinline__ unsigned pk2(float lo, float hi) { v2f v = {lo, hi}; return __builtin_bit_cast(unsigned, __builtin_convertvector(v, v2bf)); }
__device__ __forceinline__ float bflo(unsigned u) { return __uint_as_float(u << 16); }
__device__ __forceinline__ float bfhi(unsigned u) { return __uint_as_float(u & 0xffff0000u); }
__device__ __forceinline__ float wave_sum(float v) {
#pragma unroll
    for (int o = 1; o < 64; o <<= 1) v += __shfl_xor(v, o);
    return v;
}
__device__ __forceinline__ float silu_f(float x) { return x / (1.f + __expf(-x)); }
__device__ __forceinline__ float sigmoid_f(float x) { return 1.f / (1.f + __expf(-x)); }
#define MFMA32(a, b, c) __builtin_amdgcn_mfma_f32_32x32x16_bf16((a), (b), (c), 0, 0, 0)

struct Params {
    const float *x, *mem, *g_norm, *w_in, *diff_lambda, *w_mem_kv, *g_mem, *w_br_diff, *w_br_dil, *w_br_mem, *w_out, *rel_bias, *g_final;
    float* out; unsigned char* ws;
};

using pg8::f32x4;
using pg8::Unit;

__device__ __forceinline__ void seg_of(int ct, int& c0, int& w) {
    if (ct < OFF_LQ) { c0 = ct & ~1023; w = 1024; }
    else if (ct < OFF_LG) { const int k = (ct - OFF_LQ) / 1536; c0 = OFF_LQ + k * 1536; w = 1536; }
    else if (ct < OFF_GATE) { c0 = OFF_LG + ((ct - OFF_LG) & ~511); w = 512; }
    else { c0 = OFF_GATE; w = 3072; }
}
template <bool SEG> struct EpiInT {
    static constexpr bool PERM = true, AFTER_DRAIN = false, KEEP_ACC = false, HAS_INIT = false;
    bf16* Z; int ldz;
    __device__ __forceinline__ void operator()(const f32x4 (&acc)[2][2][4][2], const Unit& u, int wr, int wc, int fr, int fq) const {
        const int row0 = u.pm * 256 + wr * 64 + fr; int col0 = u.pn * 256 + wc * 32 + 8 * fq; int ld = ldz; bf16* base = Z;
        if (SEG) { int c0, w; seg_of(u.pn * 256, c0, w); base = Z + (size_t)T * c0; ld = w; col0 -= c0; }
#pragma unroll
        for (int ai = 0; ai < 2; ++ai)
#pragma unroll
            for (int m = 0; m < 4; ++m) { bf16* rowp = base + (size_t)(row0 + ai * 128 + m * 16) * ld + col0;
#pragma unroll
                for (int bj = 0; bj < 2; ++bj) { const f32x4 v0 = acc[ai][bj][m][0], v1 = acc[ai][bj][m][1];
                    v4u w; w.x = pk2(v0[0], v0[1]); w.y = pk2(v0[2], v0[3]); w.z = pk2(v1[0], v1[1]); w.w = pk2(v1[2], v1[3]);
                    *(v4u*)(rowp + bj * 128) = w; } }
    }
};

struct ChainOrder {
    pg8::StaticOrder S;
    __device__ __forceinline__ bool next(int i, Unit& u) const { if (!S.next(i >> 2, u)) return false; u.seg = i & 3; return true; }
    __device__ __forceinline__ void a_ready(const Unit&) const {}
    __device__ __forceinline__ void done(const Unit&) const {}
};
struct EpiMergeChain {
    static constexpr bool PERM = true, AFTER_DRAIN = false, KEEP_ACC = true, HAS_INIT = false;
    const bf16* Z; bf16* MB;
    static __device__ __forceinline__ float einv(float g) { return 1.f + __expf(fminf(-g, 30.f)); }
    __device__ __forceinline__ void operator()(f32x4 (&acc)[2][2][4][2], const Unit& u, int wr, int wc, int fr, int fq) const {
        const int row0 = u.pm * 256 + wr * 64 + fr, col0 = u.pn * 256 + wc * 32 + 8 * fq;
        if (u.seg == 0) return;
        if (u.seg < 3) {
            const int br = u.seg - 1;
#pragma unroll
            for (int ai = 0; ai < 2; ++ai)
#pragma unroll
                for (int m = 0; m < 4; ++m) { const bf16* zp = Z + (size_t)T * OFF_GATE + (size_t)(row0 + ai * 128 + m * 16) * 3072 + br * 1024 + col0;
#pragma unroll
                    for (int bj = 0; bj < 2; ++bj) { const v4u gc = *(const v4u*)(zp + bj * 128), gn = *(const v4u*)(zp + 1024 + bj * 128);
                        f32x4 r0, r1;
#define RAT(n_, c_) (einv(n_) * __builtin_amdgcn_rcpf(einv(c_)))
                        r0[0] = RAT(bflo(gn.x), bflo(gc.x)); r0[1] = RAT(bfhi(gn.x), bfhi(gc.x)); r0[2] = RAT(bflo(gn.y), bflo(gc.y)); r0[3] = RAT(bfhi(gn.y), bfhi(gc.y));
                        r1[0] = RAT(bflo(gn.z), bflo(gc.z)); r1[1] = RAT(bfhi(gn.z), bfhi(gc.z)); r1[2] = RAT(bflo(gn.w), bflo(gc.w)); r1[3] = RAT(bfhi(gn.w), bfhi(gc.w));
#undef RAT
                        acc[ai][bj][m][0] *= r0; acc[ai][bj][m][1] *= r1; } }
            return;
        }
#pragma unroll
        for (int ai = 0; ai < 2; ++ai) {
            v4u gq[4][2];
#pragma unroll
            for (int m = 0; m < 4; ++m)
#pragma unroll
                for (int bj = 0; bj < 2; ++bj) gq[m][bj] = *(const v4u*)(Z + (size_t)T * OFF_GATE + (size_t)(row0 + ai * 128 + m * 16) * 3072 + 2048 + col0 + bj * 128);
#pragma unroll
            for (int m = 0; m < 4; ++m) { const int row = row0 + ai * 128 + m * 16;
#pragma unroll
                for (int bj = 0; bj < 2; ++bj) { const int col = col0 + bj * 128;
                    const v4u gw = gq[m][bj];
                    const f32x4 a0 = acc[ai][bj][m][0], a1 = acc[ai][bj][m][1];
#define SG(a_, g_) ((a_) * __builtin_amdgcn_rcpf(einv(g_)))
                    v4u w; w.x = pk2(SG(a0[0], bflo(gw.x)), SG(a0[1], bfhi(gw.x))); w.y = pk2(SG(a0[2], bflo(gw.y)), SG(a0[3], bfhi(gw.y)));
                    w.z = pk2(SG(a1[0], bflo(gw.z)), SG(a1[1], bfhi(gw.z))); w.w = pk2(SG(a1[2], bflo(gw.w)), SG(a1[3], bfhi(gw.w)));
#undef SG
                    *(v4u*)(MB + (size_t)row * 1024 + col) = w; } }
        }
    }
};

struct EpiOut {
    static constexpr bool PERM = true, AFTER_DRAIN = false, KEEP_ACC = false, HAS_INIT = true;
    const float* XI; float* XO;
    __device__ __forceinline__ void init(f32x4 (&acc)[2][2][4][2], const Unit& u, int wr, int wc, int fr, int fq) const {
        const int row0 = u.pm * 256 + wr * 64 + fr, col0 = u.pn * 256 + wc * 32 + 8 * fq;
#pragma unroll
        for (int ai = 0; ai < 2; ++ai)
#pragma unroll
            for (int m = 0; m < 4; ++m) { const size_t ro = (size_t)(row0 + ai * 128 + m * 16) * 1024 + col0;
#pragma unroll
                for (int bj = 0; bj < 2; ++bj) { acc[ai][bj][m][0] = *(const f32x4*)(XI + ro + bj * 128); acc[ai][bj][m][1] = *(const f32x4*)(XI + ro + bj * 128 + 4); } }
    }
    __device__ __forceinline__ void operator()(const f32x4 (&acc)[2][2][4][2], const Unit& u, int wr, int wc, int fr, int fq) const {
        const int row0 = u.pm * 256 + wr * 64 + fr, col0 = u.pn * 256 + wc * 32 + 8 * fq;
#pragma unroll
        for (int ai = 0; ai < 2; ++ai)
#pragma unroll
            for (int m = 0; m < 4; ++m) { const size_t ro = (size_t)(row0 + ai * 128 + m * 16) * 1024 + col0;
#pragma unroll
                for (int bj = 0; bj < 2; ++bj) { *(f32x4*)(XO + ro + bj * 128) = acc[ai][bj][m][0]; *(f32x4*)(XO + ro + bj * 128 + 4) = acc[ai][bj][m][1]; } }
    }
};

__device__ __forceinline__ void p0_transpose_item(const float* W, int K, int N, bf16* WT, int ldT, LAS float* scr, int item, int lane) {
    const int nblk = N / 32, kb = item / nblk, nb = item % nblk, k0 = 64 * kb, n0 = 32 * nb;
#pragma unroll 16
    for (int i = 0; i < 32; ++i) { const int kk = 2 * i + (lane >> 5); scr[kk * 33 + (lane & 31)] = W[(size_t)(k0 + kk) * N + n0 + (lane & 31)]; }
    asm volatile("s_waitcnt lgkmcnt(0)" ::: "memory");
    const int c = lane & 7;
#pragma unroll
    for (int j = 0; j < 4; ++j) { const int n = (lane >> 3) + 8 * j; const LAS float* s = scr + (8 * c) * 33 + n;
        v4u o; o.x = pk2(s[0 * 33], s[1 * 33]); o.y = pk2(s[2 * 33], s[3 * 33]); o.z = pk2(s[4 * 33], s[5 * 33]); o.w = pk2(s[6 * 33], s[7 * 33]);
        *(v4u*)(WT + (size_t)(n0 + n) * ldT + k0 + 8 * c) = o; }
    asm volatile("s_waitcnt lgkmcnt(0)" ::: "memory");
}
__device__ __forceinline__ void rms_row_bf16(const float* xrow, const float* g, bf16* orow, int lane) {
    const v4f* xr = (const v4f*)xrow + lane; const v4f* gr = (const v4f*)g + lane;
    v4f v[4]; float s = 0.f;
#pragma unroll
    for (int j = 0; j < 4; ++j) { v[j] = xr[64 * j]; s += (v[j].x * v[j].x + v[j].y * v[j].y) + (v[j].z * v[j].z + v[j].w * v[j].w); }
    const float rstd = rsqrtf(wave_sum(s) * (1.f / 1024.f) + EPS);
    v2u* o8 = (v2u*)orow + lane;
#pragma unroll
    for (int j = 0; j < 4; ++j) { const v4f gv = gr[64 * j]; v2u o; o.x = pk2(v[j].x * rstd * gv.x, v[j].y * rstd * gv.y); o.y = pk2(v[j].z * rstd * gv.z, v[j].w * rstd * gv.w); o8[64 * j] = o; }
}
__device__ __forceinline__ void rms_row_f32(const float* xrow, const float* g, float* orow, int lane) {
    const v4f* xr = (const v4f*)xrow + lane; const v4f* gr = (const v4f*)g + lane;
    v4f v[4]; float s = 0.f;
#pragma unroll
    for (int j = 0; j < 4; ++j) { v[j] = xr[64 * j]; s += (v[j].x * v[j].x + v[j].y * v[j].y) + (v[j].z * v[j].z + v[j].w * v[j].w); }
    const float rstd = rsqrtf(wave_sum(s) * (1.f / 1024.f) + EPS);
    v4f* o = (v4f*)orow + lane;
#pragma unroll
    for (int j = 0; j < 4; ++j) { const v4f gv = gr[64 * j]; o[64 * j] = v[j] * rstd * gv; }
}
__device__ __forceinline__ int t5_bucket(int rel) {
    const int ret = rel > 0 ? 16 : 0; const int n = rel < 0 ? -rel : rel;
    const float nf = (float)(n > 1 ? n : 1);
    int large = 8 + (int)(logf(nf / 8.0f) / 4.852030263919617f * 8.0f);
    large = large < 15 ? large : 15;
    return ret + (n < 8 ? n : large);
}

template <int NM> struct AttnAcc { v16f O[NM][4]; float m[NM]; float l[NM]; };
struct BiasConst { float v; __device__ __forceinline__ float operator()(int) const { return v; } };
struct BiasToeplitz { const LAS float* tp; __device__ __forceinline__ float operator()(int i) const { return tp[(i & 3) + 8 * (i >> 2)]; } };
struct BiasBand { const LAS float* tab; int d0; __device__ __forceinline__ float operator()(int i) const { const int delta = d0 + (i & 3) + 8 * (i >> 2); const int ad = delta < 0 ? -delta : delta;
    const int idx = (delta < -64 ? -64 : (delta > 64 ? 64 : delta)) + 64; return ad <= 64 ? tab[idx] : NEGBIG; } };

template <int D, int NM, int KSTR, int VSTR, bool QLDS, class BF>
__device__ __forceinline__ void attn_subtile(const LAS unsigned char* K0, const LAS unsigned char* K1, const LAS unsigned char* Vb, const int kk,
                                             const v8s (&Q)[NM][D / 16], const LAS unsigned char* qlds, AttnAcc<NM>& st, const float c1, const BF& bias, const int r, const int h) {
    v8s P[NM][2];
#pragma unroll
    for (int m = 0; m < NM; ++m) {
        const LAS unsigned char* Kb = (m == 0 ? K0 : K1) + (32 * kk + r) * KSTR + h * 16;
        v16f S;
#pragma unroll
        for (int i = 0; i < 16; ++i) S[i] = 0.f;
        v8s kfa[D / 16];
#pragma unroll
        for (int ks = 0; ks < D / 16; ++ks) kfa[ks] = *(const LAS v8s*)(Kb + ks * 32);
        __builtin_amdgcn_sched_barrier(0);
#pragma unroll
        for (int ks = 0; ks < D / 16; ++ks) { const v8s qf = QLDS ? *(const LAS v8s*)(qlds + (m * (D / 16) + ks) * 1024) : Q[m][ks]; S = MFMA32(kfa[ks], qf, S); }
        __builtin_amdgcn_sched_barrier(0);
        float tmax = NEGBIG;
#pragma unroll
        for (int i = 0; i < 16; ++i) { S[i] = S[i] * c1 + bias(i); tmax = fmaxf(tmax, S[i]); }
        tmax = fmaxf(tmax, __shfl_xor(tmax, 32));
        const float mo = st.m[m], mn = fmaxf(mo, tmax);
        if (__any(mn > mo)) {
            const float alpha = __builtin_amdgcn_exp2f(mo - mn);
            st.l[m] *= alpha;
#pragma unroll
            for (int eb = 0; eb < 4; ++eb)
#pragma unroll
                for (int i = 0; i < 16; ++i) st.O[m][eb][i] *= alpha;
            st.m[m] = mn;
        }
        float ps = 0.f;
#pragma unroll
        for (int i = 0; i < 16; ++i) { S[i] = __builtin_amdgcn_exp2f(S[i] - mn); ps += S[i]; }
        st.l[m] += ps;
#pragma unroll
        for (int s2 = 0; s2 < 2; ++s2) { v4u w; w.x = pk2(S[8 * s2 + 0], S[8 * s2 + 1]); w.y = pk2(S[8 * s2 + 2], S[8 * s2 + 3]); w.z = pk2(S[8 * s2 + 4], S[8 * s2 + 5]); w.w = pk2(S[8 * s2 + 6], S[8 * s2 + 7]);
            P[m][s2] = __builtin_bit_cast(v8s, w); }
    }
    const int lane_ = h * 32 + r, q_ = (lane_ >> 2) & 3, p_ = lane_ & 3, g1_ = (lane_ >> 4) & 1;
    const LAS unsigned char* vb0 = Vb + ((32 * kk + 4 * h + q_) * VSTR + (16 * g1_ + 4 * p_) * 2);
#pragma unroll
    for (int s2 = 0; s2 < 2; ++s2) {
        const LAS unsigned char* va = vb0 + 16 * s2 * VSTR;
        v8s vfa[4];
#pragma unroll
        for (int eb = 0; eb < 4; ++eb) {
            const v4s lo = __builtin_amdgcn_ds_read_tr16_b64_v4i16((LAS v4s*)(va + 64 * eb)), hi = __builtin_amdgcn_ds_read_tr16_b64_v4i16((LAS v4s*)(va + 64 * eb + 8 * VSTR));
            vfa[eb] = __builtin_shufflevector(lo, hi, 0, 1, 2, 3, 4, 5, 6, 7); }
        __builtin_amdgcn_sched_barrier(0);
#pragma unroll
        for (int eb = 0; eb < 4; ++eb)
#pragma unroll
            for (int m = 0; m < NM; ++m) st.O[m][eb] = MFMA32(vfa[eb], P[m][s2], st.O[m][eb]);
        __builtin_amdgcn_sched_barrier(0);
    }
}
template <int NM> __device__ __forceinline__ void attn_init(AttnAcc<NM>& st) {
#pragma unroll
    for (int m = 0; m < NM; ++m) { st.m[m] = NEGBIG; st.l[m] = 0.f;
#pragma unroll
        for (int eb = 0; eb < 4; ++eb)
#pragma unroll
            for (int i = 0; i < 16; ++i) st.O[m][eb][i] = 0.f; }
}

constexpr int DF_K0 = 0, DF_K1 = 18432, DF_VT = 36864, DF_TAB = 77824, DF_Q = 83328;
__device__ __forceinline__ void diff_item(const Params& p, LAS unsigned char* lds, const int item, const int layer, const float lam, const float lam_init) {
    int tid_l = threadIdx.x; asm volatile("" : "+v"(tid_l));
    const int tid = tid_l, lane = tid & 63, wave = tid >> 6, r = lane & 31, h = lane >> 5;
    const int b = item >> 6, hh = (item >> 3) & 7, qb = item & 7;
    const bf16* Z = (const bf16*)(p.ws + WS_Z); bf16* AA = (bf16*)(p.ws + WS_AA);
    const float* gtab = (const float*)(p.ws + WS_TAB) + hh * 4096;
    LAS float* tab = (LAS float*)(lds + DF_TAB);
    const int q0w = qb * 256 + wave * 32; const size_t tq = (size_t)b * 2048 + q0w + r;
    __syncthreads();
    for (int i = tid; i < 1345; i += 512) tab[i] = gtab[i + 2047 - 672];
    LAS unsigned char* qlds = lds + DF_Q + wave * 8192 + lane * 16;
#pragma unroll
    for (int m = 0; m < 2; ++m)
#pragma unroll
        for (int ks = 0; ks < 4; ++ks) *(LAS v4u*)(qlds + (m * 4 + ks) * 1024) = *(const v4u*)(Z + tq * NIN + OFF_DQ + m * 512 + hh * 64 + ks * 16 + h * 8);
    v8s Qdummy[2][4];
#pragma unroll
    for (int m = 0; m < 2; ++m)
#pragma unroll
        for (int ks = 0; ks < 4; ++ks) Qdummy[m][ks] = (v8s){0, 0, 0, 0, 0, 0, 0, 0};
    AttnAcc<2> st; attn_init<2>(st);
    const int rowK = tid >> 3, cc = tid & 7, rowV = tid >> 4, ccV = tid & 15;
    const bf16* sK = Z + ((size_t)b * 2048 + rowK) * NIN + OFF_DK + hh * 64 + cc * 8;
    const bf16* sV = Z + ((size_t)b * 2048 + rowV) * NIN + OFF_DV + hh * 128 + ccV * 8;
    LAS unsigned char* dK0 = lds + DF_K0 + rowK * 144 + cc * 16; LAS unsigned char* dK1 = lds + DF_K1 + rowK * 144 + cc * 16;
    LAS unsigned char* dV = lds + DF_VT + rowV * 320 + ccV * 16;
    const float c1 = 0.125f * LOG2E;
    const float bpos = gtab[2047 + 1024], bneg = gtab[2047 - 1024];
    v4u g0 = *(const v4u*)sK, g1 = *(const v4u*)(sK + 512), g2 = *(const v4u*)sV, g3 = *(const v4u*)(sV + (size_t)32 * NIN);
#pragma unroll 1
    for (int t = 0; t < 32; ++t) {
        __syncthreads();
        *(LAS v4u*)dK0 = g0; *(LAS v4u*)dK1 = g1; *(LAS v4u*)dV = g2; *(LAS v4u*)(dV + 32 * 320) = g3;
        __syncthreads();
        if (t + 1 < 32) { const bf16* nK = sK + (size_t)(t + 1) * 64 * NIN; const bf16* nV = sV + (size_t)(t + 1) * 64 * NIN;
            g0 = *(const v4u*)nK; g1 = *(const v4u*)(nK + 512); g2 = *(const v4u*)nV; g3 = *(const v4u*)(nV + (size_t)32 * NIN); }
        const int k0 = t * 64;
#pragma unroll 1
        for (int kk = 0; kk < 2; ++kk) {
            const int lo_rel = k0 + 32 * kk - (q0w + 31), hi_rel = k0 + 32 * kk + 31 - q0w;
            if (lo_rel >= 600) { const BiasConst bf{bpos}; attn_subtile<64, 2, 144, 320, true>(lds + DF_K0, lds + DF_K1, lds + DF_VT, kk, Qdummy, qlds, st, c1, bf, r, h); }
            else if (hi_rel <= -600) { const BiasConst bf{bneg}; attn_subtile<64, 2, 144, 320, true>(lds + DF_K0, lds + DF_K1, lds + DF_VT, kk, Qdummy, qlds, st, c1, bf, r, h); }
            else { const BiasToeplitz bf{tab + (k0 + 32 * kk + 4 * h - (q0w + r) + 672)}; attn_subtile<64, 2, 144, 320, true>(lds + DF_K0, lds + DF_K1, lds + DF_VT, kk, Qdummy, qlds, st, c1, bf, r, h); }
        }
    }
    int item2 = item, tid2 = threadIdx.x; asm volatile("" : "+s"(item2), "+v"(tid2));
    const int b2 = item2 >> 6, hh2 = (item2 >> 3) & 7, qb2 = item2 & 7;
    const size_t tq2 = (size_t)b2 * 2048 + qb2 * 256 + (tid2 >> 6) * 32 + (tid2 & 31); const int h2 = (tid2 >> 5) & 1;
    const float l0 = st.l[0] + __shfl_xor(st.l[0], 32), l1 = st.l[1] + __shfl_xor(st.l[1], 32);
    const float i0 = 1.f / l0, i1 = lam / l1;
    float ss = 0.f;
#pragma unroll
    for (int eb = 0; eb < 4; ++eb)
#pragma unroll
        for (int i = 0; i < 16; ++i) { const float o = st.O[0][eb][i] * i0 - st.O[1][eb][i] * i1; st.O[0][eb][i] = o; ss += o * o; }
    ss += __shfl_xor(ss, 32);
    const float rn = rsqrtf(ss * (1.f / 128.f) + EPS) * (1.f - lam_init);
#pragma unroll
    for (int eb = 0; eb < 4; ++eb)
#pragma unroll
        for (int q4 = 0; q4 < 4; ++q4) { const int e0 = 32 * eb + 8 * q4 + 4 * h2;
            const v2u gw = *(const v2u*)(Z + tq2 * NIN + OFF_DG + hh2 * 128 + e0);
            v2u o; o.x = pk2(st.O[0][eb][4 * q4 + 0] * rn * silu_f(bflo(gw.x)), st.O[0][eb][4 * q4 + 1] * rn * silu_f(bfhi(gw.x)));
            o.y = pk2(st.O[0][eb][4 * q4 + 2] * rn * silu_f(bflo(gw.y)), st.O[0][eb][4 * q4 + 3] * rn * silu_f(bfhi(gw.y)));
            *(v2u*)(AA + tq2 * 2048 + hh2 * 128 + e0) = o; }
}

constexpr int STG_OFF = 83456, STG_WAVE = 8704;
__device__ __forceinline__ void stg_write(LAS unsigned char* wbuf, const v16f (&O)[4], const float scale, const int r, const int h) {
#pragma unroll
    for (int eb = 0; eb < 4; ++eb)
#pragma unroll
        for (int q4 = 0; q4 < 4; ++q4) { v2u o; o.x = pk2(O[eb][4 * q4 + 0] * scale, O[eb][4 * q4 + 1] * scale); o.y = pk2(O[eb][4 * q4 + 2] * scale, O[eb][4 * q4 + 3] * scale);
            *(LAS v2u*)(wbuf + r * 272 + (32 * eb + 8 * q4 + 4 * h) * 2) = o; }
}
__device__ __forceinline__ v4u gate_silu8(const v4u o, const v4u g) {
    v4u w;
    w.x = pk2(bflo(o.x) * silu_f(bflo(g.x)), bfhi(o.x) * silu_f(bfhi(g.x))); w.y = pk2(bflo(o.y) * silu_f(bflo(g.y)), bfhi(o.y) * silu_f(bfhi(g.y)));
    w.z = pk2(bflo(o.z) * silu_f(bflo(g.z)), bfhi(o.z) * silu_f(bfhi(g.z))); w.w = pk2(bflo(o.w) * silu_f(bflo(g.w)), bfhi(o.w) * silu_f(bfhi(g.w)));
    return w;
}
constexpr int D2_K1 = 9216, D2_KB = 18432, D2_VR = 36864, D2_VB = 20480, D2_TAB = 77824;
__device__ __forceinline__ void d2_qk(const LAS unsigned char* Kb, const v8s (&Q)[4], v16f& S) {
    const v16f z = {0.f, 0.f, 0.f, 0.f, 0.f, 0.f, 0.f, 0.f, 0.f, 0.f, 0.f, 0.f, 0.f, 0.f, 0.f, 0.f};
    const v8s k0 = *(const LAS v8s*)Kb, k1 = *(const LAS v8s*)(Kb + 32), k2 = *(const LAS v8s*)(Kb + 64), k3 = *(const LAS v8s*)(Kb + 96);
    __builtin_amdgcn_sched_barrier(0);
    S = MFMA32(k0, Q[0], z); S = MFMA32(k1, Q[1], S); S = MFMA32(k2, Q[2], S); S = MFMA32(k3, Q[3], S);
    __builtin_amdgcn_sched_barrier(0);
}
__device__ __forceinline__ void d2_softmax(v16f& S, const float c1, const LAS float* tp, float& m, float& l, v16f (&O)[4], v8s (&P)[2]) {
    float tmax = NEGBIG;
#pragma unroll
    for (int i = 0; i < 16; ++i) { S[i] = S[i] * c1 + tp[(i & 3) + 8 * (i >> 2)]; tmax = fmaxf(tmax, S[i]); }
    tmax = fmaxf(tmax, __shfl_xor(tmax, 32));
    const float mo = m;
    if (__any(tmax > mo + 8.f)) {
        const float mn = (tmax > mo + 8.f) ? tmax : mo;
        const float alpha = __builtin_amdgcn_exp2f(mo - mn);
        l *= alpha;
#pragma unroll
        for (int eb = 0; eb < 4; ++eb)
#pragma unroll
            for (int i = 0; i < 16; ++i) O[eb][i] *= alpha;
        m = mn;
    }
    const float mc = m;
    float ps = 0.f;
#pragma unroll
    for (int i = 0; i < 16; ++i) { S[i] = __builtin_amdgcn_exp2f(S[i] - mc); ps += S[i]; }
    l += ps;
#pragma unroll
    for (int s2 = 0; s2 < 2; ++s2) { v4u w; w.x = pk2(S[8 * s2 + 0], S[8 * s2 + 1]); w.y = pk2(S[8 * s2 + 2], S[8 * s2 + 3]); w.z = pk2(S[8 * s2 + 4], S[8 * s2 + 5]); w.w = pk2(S[8 * s2 + 6], S[8 * s2 + 7]);
        P[s2] = __builtin_bit_cast(v8s, w); }
}
#define TRR(p_) __builtin_amdgcn_ds_read_tr16_b64_v4i16((LAS v4s*)(p_))
__device__ __forceinline__ void d2_pv(const LAS unsigned char* vb0, const v8s (&P)[2], v16f (&O)[4]) {
    const LAS unsigned char* va = vb0; const LAS unsigned char* vc = vb0 + 16 * 320;
    const v4s l0 = TRR(va), h0 = TRR(va + 2560), l1 = TRR(va + 64), h1 = TRR(va + 2624), l2 = TRR(va + 128), h2 = TRR(va + 2688), l3 = TRR(va + 192), h3 = TRR(va + 2752);
    __builtin_amdgcn_sched_barrier(0);
    const v4s m0 = TRR(vc), n0 = TRR(vc + 2560), m1 = TRR(vc + 64), n1 = TRR(vc + 2624), m2 = TRR(vc + 128), n2 = TRR(vc + 2688), m3 = TRR(vc + 192), n3 = TRR(vc + 2752);
    O[0] = MFMA32(__builtin_shufflevector(l0, h0, 0, 1, 2, 3, 4, 5, 6, 7), P[0], O[0]);
    O[1] = MFMA32(__builtin_shufflevector(l1, h1, 0, 1, 2, 3, 4, 5, 6, 7), P[0], O[1]);
    O[2] = MFMA32(__builtin_shufflevector(l2, h2, 0, 1, 2, 3, 4, 5, 6, 7), P[0], O[2]);
    O[3] = MFMA32(__builtin_shufflevector(l3, h3, 0, 1, 2, 3, 4, 5, 6, 7), P[0], O[3]);
    __builtin_amdgcn_sched_barrier(0);
    O[0] = MFMA32(__builtin_shufflevector(m0, n0, 0, 1, 2, 3, 4, 5, 6, 7), P[1], O[0]);
    O[1] = MFMA32(__builtin_shufflevector(m1, n1, 0, 1, 2, 3, 4, 5, 6, 7), P[1], O[1]);
    O[2] = MFMA32(__builtin_shufflevector(m2, n2, 0, 1, 2, 3, 4, 5, 6, 7), P[1], O[2]);
    O[3] = MFMA32(__builtin_shufflevector(m3, n3, 0, 1, 2, 3, 4, 5, 6, 7), P[1], O[3]);
    __builtin_amdgcn_sched_barrier(0);
}
#define SB() __builtin_amdgcn_sched_barrier(0)
__device__ __forceinline__ void d2_ldk(const LAS unsigned char* Kb, v8s (&kf)[4]) {
#pragma unroll
    for (int ks = 0; ks < 4; ++ks) kf[ks] = *(const LAS v8s*)(Kb + ks * 32);
}
__device__ __forceinline__ void d2_mmk(const v8s (&kf)[4], const v8s (&Q)[4], v16f& S) {
    const v16f z = {0.f, 0.f, 0.f, 0.f, 0.f, 0.f, 0.f, 0.f, 0.f, 0.f, 0.f, 0.f, 0.f, 0.f, 0.f, 0.f};
    S = MFMA32(kf[0], Q[0], z);
#pragma unroll
    for (int ks = 1; ks < 4; ++ks) S = MFMA32(kf[ks], Q[ks], S);
}
__device__ __forceinline__ void d2_ldv(const LAS unsigned char* va, v8s (&vf)[4]) {
#pragma unroll
    for (int eb = 0; eb < 4; ++eb) { const v4s lo = TRR(va + 64 * eb), hi = TRR(va + 64 * eb + 8 * 320); vf[eb] = __builtin_shufflevector(lo, hi, 0, 1, 2, 3, 4, 5, 6, 7); }
}
__device__ __forceinline__ void d2_mmv(const v8s (&vf)[4], const v8s& P, v16f (&O)[4]) {
#pragma unroll
    for (int eb = 0; eb < 4; ++eb) O[eb] = MFMA32(vf[eb], P, O[eb]);
}
template <bool DOQK, bool DOPV>
__device__ __forceinline__ void d2_segY(const LAS unsigned char* kbase, const LAS unsigned char* vbase, const v8s (&Q)[4], v16f& S0, v16f& S1, const v8s (&P0)[2], const v8s (&P1)[2], v16f (&O)[4]) {
    if (DOQK) {
        { v8s f[4]; d2_ldk(kbase, f); SB(); d2_mmk(f, Q, S0); SB(); }
        { v8s f[4]; d2_ldk(kbase + 32 * 144, f); SB(); d2_mmk(f, Q, S1); SB(); }
    }
    if (DOPV) {
        { v8s f[4]; d2_ldv(vbase, f); SB(); d2_mmv(f, P0[0], O); SB(); }
        { v8s f[4]; d2_ldv(vbase + 16 * 320, f); SB(); d2_mmv(f, P0[1], O); SB(); }
        { v8s f[4]; d2_ldv(vbase + 32 * 320, f); SB(); d2_mmv(f, P1[0], O); SB(); }
        { v8s f[4]; d2_ldv(vbase + 48 * 320, f); SB(); d2_mmv(f, P1[1], O); SB(); }
    }
}
__device__ __forceinline__ void diff2_item(const Params& p, LAS unsigned char* lds, const int item, const float lam, const float lam_init) {
    int tid_l = threadIdx.x; asm volatile("" : "+v"(tid_l));
    const int tid = tid_l, lane = tid & 63, wave = tid >> 6, r = lane & 31, h = lane >> 5, mp = wave >> 2, qs = wave & 3;
    const int b = item >> 7, hh = (item >> 4) & 7, qb = item & 15;
    const bf16* Z = (const bf16*)(p.ws + WS_Z); bf16* AA = (bf16*)(p.ws + WS_AA);
    const float* gtab = (const float*)(p.ws + WS_TAB) + hh * 4096;
    LAS float* tab = (LAS float*)(lds + D2_TAB);
    const int q0w = qb * 128 + qs * 32; const size_t tq = (size_t)b * 2048 + q0w + r;
    __syncthreads();
    for (int i = tid; i < 1345; i += 512) tab[i] = gtab[i + 2047 - 672];
    v8s Q[4];
#pragma unroll
    for (int ks = 0; ks < 4; ++ks) Q[ks] = *(const v8s*)(Z + (size_t)T * OFF_DQ + tq * 1024 + mp * 512 + hh * 64 + ks * 16 + h * 8);
    v16f O[4]; float m_ = NEGBIG, l_ = 0.f;
#pragma unroll
    for (int eb = 0; eb < 4; ++eb)
#pragma unroll
        for (int i = 0; i < 16; ++i) O[eb][i] = 0.f;
    const int rowK = tid >> 3, cc = tid & 7, rowV = tid >> 4, ccV = tid & 15;
    const unsigned char* Zt = (const unsigned char*)(Z + (size_t)T * OFF_DK + ((size_t)b * 2048) * 1024 + hh * 64);
    const unsigned char* ZtV = (const unsigned char*)(Z + (size_t)T * OFF_DV + ((size_t)b * 2048) * 1024 + hh * 128);
    const unsigned oK = (unsigned)(rowK * 1024 + cc * 8) * 2u;
    const unsigned oV = (unsigned)(rowV * 1024 + ccV * 8) * 2u;
    LAS unsigned char* dK = lds + rowK * 144 + cc * 16;
    LAS unsigned char* dV = lds + D2_VR + rowV * 320 + ccV * 16;
#define D2_LOADK(tt) do { const unsigned char* zt_ = Zt + (size_t)(tt) * (64 * 1024 * 2); gk0 = *(const v4u*)(zt_ + oK); gk1 = *(const v4u*)(zt_ + oK + 1024); } while (0)
#define D2_LOADV(tt) do { const unsigned char* zt_ = ZtV + (size_t)(tt) * (64 * 1024 * 2); gv0 = *(const v4u*)(zt_ + oV); gv1 = *(const v4u*)(zt_ + oV + 32 * 1024 * 2); } while (0)
    v4u gk0, gk1, gv0, gv1;
    D2_LOADK(0);
    *(LAS v4u*)dK = gk0; *(LAS v4u*)(dK + D2_K1) = gk1;
    D2_LOADK(1); D2_LOADV(0);
    __syncthreads();
    const float c1 = 0.125f * LOG2E;
    const LAS unsigned char* kb0 = lds + mp * D2_K1 + r * 144 + h * 16;
    const int q_ = (lane >> 2) & 3, p_ = lane & 3, g1_ = (lane >> 4) & 1;
    const LAS unsigned char* vb_lane = lds + D2_VR + ((4 * h + q_) * 320 + (16 * g1_ + 4 * p_) * 2);
    const int rel0 = 4 * h - (q0w + r);
    v16f S0, S1; v8s P0[2], P1[2];
#define D2_X(t_) do { int i0_ = (t_) * 64 + rel0; i0_ = i0_ < -672 ? -672 : (i0_ > 640 ? 640 : i0_); d2_softmax(S0, c1, tab + (i0_ + 672), m_, l_, O, P0); \
                      int i1_ = (t_) * 64 + 32 + rel0; i1_ = i1_ < -672 ? -672 : (i1_ > 640 ? 640 : i1_); d2_softmax(S1, c1, tab + (i1_ + 672), m_, l_, O, P1); } while (0)
#define D2_Y(t_) do { if ((t_) + 1 < 32) { const LAS unsigned char* kb_ = kb0 + (((t_) + 1) & 1) * D2_KB; d2_qk(kb_, Q, S0); d2_qk(kb_ + 32 * 144, Q, S1); } \
                      if ((t_) >= 0) { const LAS unsigned char* vb_ = vb_lane + ((t_) & 1) * D2_VB; d2_pv(vb_, P0, O); d2_pv(vb_ + 32 * 320, P1, O); } } while (0)
    if (mp == 0) D2_Y(-1);
    __syncthreads();
#pragma unroll 1
    for (int t = 0; t < 32; ++t) {
        if (t + 1 < 32) { LAS unsigned char* d_ = dK + ((t + 1) & 1) * D2_KB; *(LAS v4u*)d_ = gk0; *(LAS v4u*)(d_ + D2_K1) = gk1; }
        { LAS unsigned char* d_ = dV + (t & 1) * D2_VB; *(LAS v4u*)d_ = gv0; *(LAS v4u*)(d_ + 32 * 320) = gv1; }
        if (t + 2 < 32) D2_LOADK(t + 2);
        if (t + 1 < 32) D2_LOADV(t + 1);
        if (mp == 0) D2_X(t); else D2_Y(t - 1);
        __syncthreads();
        if (mp == 0) D2_Y(t); else D2_X(t);
        __syncthreads();
    }
    if (mp == 1) D2_Y(31);
    __syncthreads();
    const float lt = l_ + __shfl_xor(l_, 32);
    LAS float* X = (LAS float*)(lds + qs * 16384) + lane;
    if (mp == 1) { const float i1 = lam / lt;
#pragma unroll
        for (int eb = 0; eb < 4; ++eb)
#pragma unroll
            for (int i = 0; i < 16; ++i) X[(eb * 16 + i) * 64] = O[eb][i] * i1; }
    __syncthreads();
    if (mp == 0) {
        const float i0 = 1.f / lt; float ss = 0.f;
#pragma unroll
        for (int eb = 0; eb < 4; ++eb)
#pragma unroll
            for (int i = 0; i < 16; ++i) { const float o = O[eb][i] * i0 - X[(eb * 16 + i) * 64]; O[eb][i] = o; ss += o * o; }
        ss += __shfl_xor(ss, 32);
        const float rn = rsqrtf(ss * (1.f / 128.f) + EPS) * (1.f - lam_init);
        LAS unsigned char* wbuf = lds + STG_OFF + qs * STG_WAVE;
        stg_write(wbuf, O, rn, r, h);
        v4u gg[8];
#pragma unroll
        for (int it = 0; it < 8; ++it) { const int row = it * 4 + (lane >> 4), ch = lane & 15; const size_t tr = (size_t)b * 2048 + q0w + row;
            gg[it] = *(const v4u*)(Z + (size_t)T * OFF_DG + tr * 1024 + hh * 128 + ch * 8); }
#pragma unroll
        for (int it = 0; it < 8; ++it) { const int row = it * 4 + (lane >> 4), ch = lane & 15; const size_t tr = (size_t)b * 2048 + q0w + row;
            const v4u o = *(const LAS v4u*)(wbuf + row * 272 + ch * 16);
            *(v4u*)(AA + tr * 2048 + hh * 128 + ch * 8) = gate_silu8(o, gg[it]); }
    }
}

constexpr int MM_K = 0, MM_VT = 17408;
__device__ __forceinline__ void mem_item(const Params& p, LAS unsigned char* lds, const int item, const int layer) {
    int tid_l = threadIdx.x; asm volatile("" : "+v"(tid_l));
    const int tid = tid_l, lane = tid & 63, wave = tid >> 6, r = lane & 31, h = lane >> 5;
    const int b = item >> 5, hh = (item >> 3) & 3, qb = item & 7;
    const bf16* Z = (const bf16*)(p.ws + WS_Z); bf16* AM = (bf16*)(p.ws + WS_AA);
    const bf16* MKV = (const bf16*)(p.ws + WS_MEMK) + (size_t)layer * 2048 * 1024;
    const size_t tq = (size_t)b * 2048 + qb * 256 + wave * 32 + r;
    v8s Q[1][8];
#pragma unroll
    for (int ks = 0; ks < 8; ++ks) Q[0][ks] = *(const v8s*)(Z + (size_t)T * OFF_MQ + tq * 512 + hh * 128 + ks * 16 + h * 8);
    AttnAcc<1> st; attn_init<1>(st);
    const int rowK = tid >> 4, ccK = tid & 15;
    const bf16* sK = MKV + ((size_t)b * 256 + rowK) * 1024 + hh * 128 + ccK * 8;
    LAS unsigned char* dK = lds + MM_K + rowK * 272 + ccK * 16; LAS unsigned char* dV = lds + MM_VT + rowK * 320 + ccK * 16;
    v4u g0 = *(const v4u*)sK, g1 = *(const v4u*)(sK + 32 * 1024), g2 = *(const v4u*)(sK + 512), g3 = *(const v4u*)(sK + 32 * 1024 + 512);
    const float c1 = 0.08838834764831845f * LOG2E;
    const BiasConst bf{0.f};
    for (int t = 0; t < 4; ++t) {
        __syncthreads();
        *(LAS v4u*)dK = g0; *(LAS v4u*)(dK + 32 * 272) = g1; *(LAS v4u*)dV = g2; *(LAS v4u*)(dV + 32 * 320) = g3;
        __syncthreads();
        if (t + 1 < 4) { const bf16* nK = sK + (size_t)(t + 1) * 64 * 1024;
            g0 = *(const v4u*)nK; g1 = *(const v4u*)(nK + 32 * 1024); g2 = *(const v4u*)(nK + 512); g3 = *(const v4u*)(nK + 32 * 1024 + 512); }
#pragma unroll
        for (int kk = 0; kk < 2; ++kk) attn_subtile<128, 1, 272, 320, false>(lds + MM_K, lds + MM_K, lds + MM_VT, kk, Q, nullptr, st, c1, bf, r, h);
    }
    const float l0 = st.l[0] + __shfl_xor(st.l[0], 32), i0 = 1.f / l0;
    LAS unsigned char* wbuf = lds + STG_OFF + wave * STG_WAVE;
    stg_write(wbuf, st.O[0], i0, r, h);
    v4u gg[8];
#pragma unroll
    for (int it = 0; it < 8; ++it) { const int row = it * 4 + (lane >> 4), ch = lane & 15; const size_t tr = (size_t)b * 2048 + qb * 256 + wave * 32 + row;
        gg[it] = *(const v4u*)(Z + (size_t)T * OFF_MG + tr * 512 + hh * 128 + ch * 8); }
#pragma unroll
    for (int it = 0; it < 8; ++it) { const int row = it * 4 + (lane >> 4), ch = lane & 15; const size_t tr = (size_t)b * 2048 + qb * 256 + wave * 32 + row;
        const v4u o = *(const LAS v4u*)(wbuf + row * 272 + ch * 16);
        *(v4u*)(AM + tr * 2048 + 1536 + hh * 128 + ch * 8) = gate_silu8(o, gg[it]); }
}

constexpr int DL_SUB = 37888, DL_K = 0, DL_VT = 17408, DL_TAB = 75776;
__device__ __forceinline__ void dil_item(const Params& p, LAS unsigned char* lds, const int bitem) {
    int tid_l = threadIdx.x; asm volatile("" : "+v"(tid_l));
    const int tid = tid_l, lane = tid & 63, wave = tid >> 6, r = lane & 31, h = lane >> 5, sub = wave >> 2, wq = wave & 3, ht = tid & 255;
    const int sid = 2 * bitem + sub, g = sid >> 9, rem = sid & 511;
    const int sh = 2 * g, dil = 1 << sh, L = 2048 >> sh, nI = L >> 7;
    const int ii = rem % nI, cls = (rem / nI) & (dil - 1), hh = (rem >> 4) & 3, b = rem >> 6;
    const bf16* Z = (const bf16*)(p.ws + WS_Z);
    bf16* OG = (bf16*)(p.ws + WS_OG) + (size_t)g * T * 512; float* LSE = (float*)(p.ws + WS_LSE) + (size_t)g * T * 4;
    const float* gtab = (const float*)(p.ws + WS_TAB) + 65536 + (g * 4 + hh) * 132;
    LAS unsigned char* base = lds + sub * DL_SUB;
    LAS float* tab = (LAS float*)(lds + DL_TAB) + sub * 132;
    const int jq0 = 128 * ii + 32 * wq, jq = jq0 + r;
    const size_t tq = (size_t)b * 2048 + (size_t)jq * dil + cls;
    __syncthreads();
    if (ht < 129) tab[ht] = gtab[ht];
    v8s Q[1][8];
#pragma unroll
    for (int ks = 0; ks < 8; ++ks) Q[0][ks] = *(const v8s*)(Z + (size_t)T * OFF_LQ + tq * 1536 + g * 512 + hh * 128 + ks * 16 + h * 8);
    AttnAcc<1> st; attn_init<1>(st);
    const int rowK = ht >> 4, ccK = ht & 15;
    const bf16* sKb = Z + (size_t)T * OFF_LK + ((size_t)b * 2048 + cls) * 1536 + g * 512 + hh * 128 + ccK * 8;
    LAS unsigned char* dK = base + DL_K + rowK * 272 + ccK * 16; LAS unsigned char* dV = base + DL_VT + rowK * 320 + ccK * 16;
    const int jbase = 128 * ii - 64;
    const float c1 = 0.08838834764831845f * LOG2E;
    v4u gk[4], gv[4];
#define DL_LOAD(j0_) do { if ((j0_) >= 0 && (j0_) < L) { _Pragma("unroll") for (int i = 0; i < 4; ++i) { const bf16* sp = sKb + (size_t)((j0_) + rowK + 16 * i) * dil * 1536; gk[i] = *(const v4u*)sp; gv[i] = *(const v4u*)(sp + (size_t)T * (OFF_LV - OFF_LK)); } } } while (0)
    DL_LOAD(jbase);
#pragma unroll 1
    for (int t = 0; t < 4; ++t) {
        const int j0 = jbase + 64 * t; const bool act = (j0 >= 0 && j0 < L);
        __syncthreads();
        if (act) {
#pragma unroll
            for (int i = 0; i < 4; ++i) { *(LAS v4u*)(dK + 16 * i * 272) = gk[i]; *(LAS v4u*)(dV + 16 * i * 320) = gv[i]; } }
        __syncthreads();
        if (t + 1 < 4) DL_LOAD(j0 + 64);
        if (act) {
#pragma unroll
            for (int kk = 0; kk < 2; ++kk) {
                const int js = j0 + 32 * kk;
                if (js + 31 >= jq0 - 64 && js <= jq0 + 31 + 64) {
                    const BiasBand bf{tab, js + 4 * h - jq};
                    attn_subtile<128, 1, 272, 320, false>(base + DL_K, base + DL_K, base + DL_VT, kk, Q, nullptr, st, c1, bf, r, h);
                }
            }
        }
    }
    const float l0 = st.l[0] + __shfl_xor(st.l[0], 32), i0 = 1.f / l0;
    LAS unsigned char* wbuf = lds + STG_OFF + wave * STG_WAVE;
    stg_write(wbuf, st.O[0], i0, r, h);
#pragma unroll
    for (int it = 0; it < 8; ++it) { const int row = it * 4 + (lane >> 4), ch = lane & 15; const size_t tr = (size_t)b * 2048 + (size_t)(jq0 + row) * dil + cls;
        *(v4u*)(OG + tr * 512 + hh * 128 + ch * 8) = *(const LAS v4u*)(wbuf + row * 272 + ch * 16); }
    if (h == 0) LSE[tq * 4 + hh] = st.m[0] * LN2 + __logf(l0);
}

__device__ __forceinline__ void dil_combine_rows4(const Params& p, const int t0, const int stride, const int lane) {
    const bf16* Z = (const bf16*)(p.ws + WS_Z); const bf16* OG = (const bf16*)(p.ws + WS_OG); const float* LSE = (const float*)(p.ws + WS_LSE); bf16* AB = (bf16*)(p.ws + WS_AA);
    const int hh = lane >> 4;
    float a0[4], a1[4], a2[4]; v4u o0[4], o1[4], o2[4], gg[4];
#pragma unroll
    for (int k = 0; k < 4; ++k) { const size_t t = (size_t)t0 + (size_t)k * stride;
        a0[k] = LSE[t * 4 + hh]; a1[k] = LSE[((size_t)T + t) * 4 + hh]; a2[k] = LSE[((size_t)2 * T + t) * 4 + hh];
        o0[k] = *(const v4u*)(OG + t * 512 + 8 * lane); o1[k] = *(const v4u*)(OG + ((size_t)T + t) * 512 + 8 * lane); o2[k] = *(const v4u*)(OG + ((size_t)2 * T + t) * 512 + 8 * lane);
        gg[k] = *(const v4u*)(Z + (size_t)T * OFF_LG + t * 512 + 8 * lane); }
#pragma unroll
    for (int k = 0; k < 4; ++k) { const size_t t = (size_t)t0 + (size_t)k * stride;
        const float mx = fmaxf(a0[k], fmaxf(a1[k], a2[k]));
        float w0 = __expf(a0[k] - mx), w1 = __expf(a1[k] - mx), w2 = __expf(a2[k] - mx); const float inv = 1.f / (w0 + w1 + w2); w0 *= inv; w1 *= inv; w2 *= inv;
        v4u o;
#define CMB(c) pk2((w0 * bflo(o0[k].c) + w1 * bflo(o1[k].c) + w2 * bflo(o2[k].c)) * silu_f(bflo(gg[k].c)), (w0 * bfhi(o0[k].c) + w1 * bfhi(o1[k].c) + w2 * bfhi(o2[k].c)) * silu_f(bfhi(gg[k].c)))
        o.x = CMB(x); o.y = CMB(y); o.z = CMB(z); o.w = CMB(w);
#undef CMB
        *(v4u*)(AB + t * 2048 + 1024 + 8 * lane) = o; }
}
__device__ __forceinline__ void rms_rows4_bf16(const float* x, const float* g, bf16* out, const int m0, const int stride, const int lane) {
    v4f v[4][4]; float ss[4];
#pragma unroll
    for (int k = 0; k < 4; ++k) { const v4f* xr = (const v4f*)(x + ((size_t)m0 + (size_t)k * stride) * 1024) + lane; float s = 0.f;
#pragma unroll
        for (int j = 0; j < 4; ++j) { v[k][j] = xr[64 * j]; s += (v[k][j].x * v[k][j].x + v[k][j].y * v[k][j].y) + (v[k][j].z * v[k][j].z + v[k][j].w * v[k][j].w); }
        ss[k] = s; }
    const v4f* gr = (const v4f*)g + lane; v4f gv[4];
#pragma unroll
    for (int j = 0; j < 4; ++j) gv[j] = gr[64 * j];
#pragma unroll
    for (int k = 0; k < 4; ++k) { const float rstd = rsqrtf(wave_sum(ss[k]) * (1.f / 1024.f) + EPS);
        v2u* o8 = (v2u*)(out + ((size_t)m0 + (size_t)k * stride) * 1024) + lane;
#pragma unroll
        for (int j = 0; j < 4; ++j) { v2u o; o.x = pk2(v[k][j].x * rstd * gv[j].x, v[k][j].y * rstd * gv[j].y); o.y = pk2(v[k][j].z * rstd * gv[j].z, v[k][j].w * rstd * gv[j].w); o8[64 * j] = o; } }
}
__device__ __forceinline__ void rms_rows4_f32(const float* x, const float* g, float* out, const int m0, const int stride, const int lane) {
    v4f v[4][4]; float ss[4];
#pragma unroll
    for (int k = 0; k < 4; ++k) { const v4f* xr = (const v4f*)(x + ((size_t)m0 + (size_t)k * stride) * 1024) + lane; float s = 0.f;
#pragma unroll
        for (int j = 0; j < 4; ++j) { v[k][j] = xr[64 * j]; s += (v[k][j].x * v[k][j].x + v[k][j].y * v[k][j].y) + (v[k][j].z * v[k][j].z + v[k][j].w * v[k][j].w); }
        ss[k] = s; }
    const v4f* gr = (const v4f*)g + lane; v4f gv[4];
#pragma unroll
    for (int j = 0; j < 4; ++j) gv[j] = gr[64 * j];
#pragma unroll
    for (int k = 0; k < 4; ++k) { const float rstd = rsqrtf(wave_sum(ss[k]) * (1.f / 1024.f) + EPS);
        v4f* o = (v4f*)(out + ((size_t)m0 + (size_t)k * stride) * 1024) + lane;
#pragma unroll
        for (int j = 0; j < 4; ++j) o[64 * j] = v[k][j] * rstd * gv[j]; }
}
#define XB_TMO      128
#define XB_XCNT(j)  (256  + 64 * (j))
#define XB_XSUB(j)  (1280 + 64 * (j))
#define XB_XGEN(j)  (2304 + 64 * (j))
#define XB_TOP      3328
#define XB_TOPGEN   3392
#define XCD_BAR_WORDS 3456
#define XB_SPIN_CAP (1u << 18)

__device__ __forceinline__ unsigned xb_ld(unsigned* p)              { return __hip_atomic_load(p, __ATOMIC_RELAXED, __HIP_MEMORY_SCOPE_AGENT); }
__device__ __forceinline__ unsigned xb_add(unsigned* p, unsigned v) { return __hip_atomic_fetch_add(p, v, __ATOMIC_RELAXED, __HIP_MEMORY_SCOPE_AGENT); }
__device__ __forceinline__ unsigned xb_xcc_id() { return (unsigned)__builtin_amdgcn_s_getreg((3 << 11) | 20) & 0xFu; }
#define XB_SPIN(cond, bar) do { unsigned _sp = 0; while (cond) { __builtin_amdgcn_s_sleep(1); \
    if ((++_sp & 255u) == 0u) { if (xb_ld(&(bar)[XB_TMO])) break; if (_sp > XB_SPIN_CAP) { atomicAdd(&(bar)[XB_TMO], 1u); break; } } } } while (0)

struct XcdBarrier {
    unsigned* bar; unsigned x;
    volatile LAS unsigned* st;
};

__device__ __forceinline__ XcdBarrier xcd_barrier_post(unsigned* bar, volatile LAS unsigned* st) {
    XcdBarrier b; b.bar = bar; b.x = xb_xcc_id(); b.st = st;
    if (threadIdx.x == 0) (void)xb_add(&bar[XB_XCNT(b.x)], 1u);
    return b;
}
__device__ __forceinline__ void xcd_barrier_complete(unsigned* bar, unsigned x, unsigned& nloc, unsigned& nx) {
    const unsigned G = gridDim.x * gridDim.y * gridDim.z;
    unsigned sum, cnt, mine, sp = 0u;
    for (;;) {
        sum = 0u; cnt = 0u; mine = 0u;
#pragma unroll
        for (unsigned j = 0; j < 16; ++j) { const unsigned c = xb_ld(&bar[XB_XCNT(j)]); sum += c; cnt += (c > 0u) ? 1u : 0u; mine = (j == x) ? c : mine; }
        if (sum == G) break;
        __builtin_amdgcn_s_sleep(1);
        if ((++sp & 255u) == 0u) { if (xb_ld(&bar[XB_TMO])) break; if (sp > XB_SPIN_CAP) { atomicAdd(&bar[XB_TMO], 1u); break; } }
    }
    nloc = mine > 0u ? mine : 1u; nx = cnt > 0u ? cnt : 1u;
}

__device__ __forceinline__ void xcd_barrier(const XcdBarrier& b) {
    asm volatile("s_waitcnt vmcnt(0)" ::: "memory");
    __syncthreads();
    if (threadIdx.x == 0) {
        unsigned* bar = b.bar;
        __builtin_amdgcn_s_waitcnt(0);
        unsigned nloc = b.st[0], nx = b.st[1];
        if (nloc == 0u) { xcd_barrier_complete(bar, b.x, nloc, nx); b.st[0] = nloc; b.st[1] = nx; }
        const unsigned old = xb_add(&bar[XB_XSUB(b.x)], 1u);
        const unsigned gen = old / nloc;
        if (old + 1u == (gen + 1u) * nloc) {
            __builtin_amdgcn_fence(__ATOMIC_RELEASE, "agent");
            asm volatile("s_waitcnt vmcnt(0)" ::: "memory");
            const unsigned og = xb_add(&bar[XB_TOP], 1u);
            const unsigned tg = og / nx;
            if (og + 1u == (tg + 1u) * nx) xb_add(&bar[XB_TOPGEN], 1u);
            else XB_SPIN(xb_ld(&bar[XB_TOPGEN]) == tg, bar);
            __builtin_amdgcn_fence(__ATOMIC_ACQUIRE, "agent");
            xb_add(&bar[XB_XGEN(b.x)], 1u);
            asm volatile("s_waitcnt vmcnt(0)" ::: "memory");
        } else {
            XB_SPIN(xb_ld(&bar[XB_XGEN(b.x)]) == gen, bar);
            __builtin_amdgcn_fence(__ATOMIC_ACQUIRE, "agent");
            asm volatile("s_waitcnt vmcnt(0)" ::: "memory");
        }
    }
    __syncthreads();
}

__global__ void __launch_bounds__(512, 2) mega_fwd(Params p) {
    extern __shared__ __attribute__((aligned(16))) unsigned char lds_raw[];
    cg::grid_group grid = cg::this_grid();
    LAS unsigned char* lds = (LAS unsigned char*)lds_raw;
    const int tid = threadIdx.x, lane = tid & 63, wave = __builtin_amdgcn_readfirstlane(tid >> 6);
    const int G = gridDim.x, bid = blockIdx.x;
    const int gw = bid * 8 + wave, NGW = G * 8;
    unsigned char* ws = p.ws;
    bf16* Zb = (bf16*)(ws + WS_Z); bf16* Hb = (bf16*)(ws + WS_H);
    if (tid < 16) ((LAS unsigned*)(lds + LDS_MISC))[tid] = 0u;
    __syncthreads();
    const XcdBarrier xbar = xcd_barrier_post((unsigned*)(ws + WS_BAR), (volatile LAS unsigned*)(lds + LDS_MISC));

#pragma unroll 1
    for (int rep = 0; rep < PROBE_DUP_P0; ++rep) {
        LAS float* scr = (LAS float*)(lds + wave * 16384);
        constexpr int I_IN = 16 * 416, I_MKV = 16 * 32, I_BD = 16 * 32, I_BL = 8 * 32, I_BM = 8 * 32, I_OUT = 16 * 32, I_LAYER = I_IN + I_MKV + I_BD + I_BL + I_BM + I_OUT;
        for (int it = gw; it < DEPTH * I_LAYER; it += NGW) {
            const int l = it / I_LAYER; int r = it % I_LAYER;
            if (r < I_IN) { p0_transpose_item(p.w_in + (size_t)l * 1024 * NIN, 1024, NIN, (bf16*)(ws + WS_WIN) + (size_t)l * NIN * 1024, 1024, scr, r, lane); continue; } r -= I_IN;
            if (r < I_MKV) { p0_transpose_item(p.w_mem_kv + (size_t)l * 1024 * 1024, 1024, 1024, (bf16*)(ws + WS_WMKV) + (size_t)l * 1024 * 1024, 1024, scr, r, lane); continue; } r -= I_MKV;
            if (r < I_BD) { p0_transpose_item(p.w_br_diff + (size_t)l * 1024 * 1024, 1024, 1024, (bf16*)(ws + WS_WBD) + (size_t)l * 1024 * 2048, 2048, scr, r, lane); continue; } r -= I_BD;
            if (r < I_BL) { p0_transpose_item(p.w_br_dil + (size_t)l * 512 * 1024, 512, 1024, (bf16*)(ws + WS_WBD) + (size_t)l * 1024 * 2048 + 1024, 2048, scr, r, lane); continue; } r -= I_BL;
            if (r < I_BM) { p0_transpose_item(p.w_br_mem + (size_t)l * 512 * 1024, 512, 1024, (bf16*)(ws + WS_WBD) + (size_t)l * 1024 * 2048 + 1536, 2048, scr, r, lane); continue; } r -= I_BM;
            p0_transpose_item(p.w_out + (size_t)l * 1024 * 1024, 1024, 1024, (bf16*)(ws + WS_WOUT) + (size_t)l * 1024 * 1024, 1024, scr, r, lane);
        }
        for (int m = gw; m + 3 * NGW < T; m += 4 * NGW) rms_rows4_bf16(p.x, p.g_norm, Hb, m, NGW, lane);
        for (int m = gw; m < DEPTH * 2048; m += NGW) { const int l = m >> 11, row = m & 2047;
            rms_row_bf16(p.mem + (size_t)row * 1024, p.g_mem + l * 1024, (bf16*)(ws + WS_MEMN) + (size_t)m * 1024, lane); }
        float* dtab = (float*)(ws + WS_TAB);
        for (int i = bid * 512 + tid; i < 8 * 4096; i += G * 512) { const int hh = i >> 12, idx = i & 4095; if (idx < 4095) dtab[i] = p.rel_bias[t5_bucket(idx - 2047) * 20 + hh] * LOG2E; }
        for (int i = bid * 512 + tid; i < 12 * 132; i += G * 512) { const int gh = i / 132, d = i % 132; if (d < 129) { const int g = gh >> 2; dtab[65536 + i] = p.rel_bias[t5_bucket((d - 64) * (1 << (2 * g))) * 20 + 8 + gh] * LOG2E; } }
    }
    grid.sync();

#pragma unroll 1
    for (int l = 0; l < DEPTH; ++l) {
        int lane_i = tid & 63; asm volatile("" : "+v"(lane_i));
#ifndef SKIP_MKV
        if (l == 0) {
#pragma unroll 1
            for (int ll = 0; ll < DEPTH; ++ll) {
                pg8::Gemm g{(const pg8::bf16_t*)(ws + WS_MEMN) + (size_t)ll * 2048 * 1024, (const pg8::bf16_t*)(ws + WS_WMKV) + (size_t)ll * 1024 * 1024, 2048, 1024, 1024};
                pg8::StaticOrder S; S.init(2048, 1024, G, (bid + 32 * ll) % G);
                EpiInT<false> E{(bf16*)(ws + WS_MEMK) + (size_t)ll * 2048 * 1024, 1024};
                pg8::gemm_phase<EpiInT<false>, pg8::StaticOrder>(lds, g, S, E);
            }
        }
#endif
#ifndef SKIP_IN
#pragma unroll 1
        for (int rep = 0; rep < PROBE_DUP_IN; ++rep) {
            pg8::Gemm g{(const pg8::bf16_t*)Hb, (const pg8::bf16_t*)(ws + WS_WIN) + (size_t)l * NIN * 1024, T, NIN, 1024};
            pg8::StaticOrder S; S.init(T, NIN, G, bid);
            EpiInT<true> E{Zb, NIN};
            pg8::gemm_phase<EpiInT<true>, pg8::StaticOrder>(lds, g, S, E);
        }
#endif
        GSYNC();
#ifndef SKIP_B1
        for (int rep = 0; rep < PROBE_DUP_B1; ++rep)
        for (int it = bid; it < 256 + 768; it += G) { if (it < 256) mem_item(p, lds, it, l); else dil_item(p, lds, it - 256); }
#endif
        GSYNC();
        {
            const float* lp = p.diff_lambda + l * 256;
            const float lam_init = 0.8f - 0.6f * expf(-0.3f * (float)l);
            const float lam = expf(wave_sum(lp[lane_i] * lp[64 + lane_i])) - expf(wave_sum(lp[128 + lane_i] * lp[192 + lane_i])) + lam_init;
#ifndef SKIP_DIFF
            for (int rep = 0; rep < PROBE_DUP_DIFF; ++rep)
            if (G == 256) {
                const int x = bid & 7, j = bid >> 3;
                for (int i = 0; i < 4; ++i) diff2_item(p, lds, (x + 8 * (2 * i + (j >> 4))) * 16 + (j & 15), lam, lam_init);
            } else
            for (int it = bid; it < 1024; it += G) diff2_item(p, lds, it, lam, lam_init);
#endif
            for (int t = gw; t + 3 * NGW < T; t += 4 * NGW) dil_combine_rows4(p, t, NGW, lane_i);
        }
        GSYNC();
#ifndef SKIP_PC
#pragma unroll 1
        for (int rep = 0; rep < PROBE_DUP_PC; ++rep) {
            pg8::StaticOrder S; S.init(T, 1024, G, bid);
            pg8::Gemm g{(const pg8::bf16_t*)(ws + WS_AA), (const pg8::bf16_t*)(ws + WS_WBD) + (size_t)l * 1024 * 2048, T, 1024, 512};
            EpiMergeChain E{Zb, (bf16*)(ws + WS_MERGED_BF)};
            ChainOrder CS; CS.S = S;
            pg8::gemm_phase<EpiMergeChain, ChainOrder>(lds, g, CS, E);
        }
#endif
        GSYNC();
#ifndef SKIP_PD
        {
            pg8::Gemm g{(const pg8::bf16_t*)(ws + WS_MERGED_BF), (const pg8::bf16_t*)(ws + WS_WOUT) + (size_t)l * 1024 * 1024, T, 1024, 1024};
            pg8::StaticOrder S; S.init(T, 1024, G, bid);
            EpiOut E{l == 0 ? p.x : (const float*)p.out, p.out};
            pg8::gemm_phase<EpiOut, pg8::StaticOrder>(lds, g, S, E);
        }
#endif
        GSYNC();
        if (l + 1 < DEPTH) { for (int m = gw; m + 3 * NGW < T; m += 4 * NGW) rms_rows4_bf16(p.out, p.g_norm + (l + 1) * 1024, Hb, m, NGW, lane_i); GSYNC(); }
        else { for (int m = gw; m + 3 * NGW < T; m += 4 * NGW) rms_rows4_f32(p.out, p.g_final, p.out, m, NGW, lane_i); }
    }
}

extern "C" void kernel_launch(void* const* d_in, const int* in_sizes, int n_in, void* d_out, int out_size, void* d_ws, size_t ws_size, hipStream_t stream) {
    static int grid = 0;
    if (grid == 0) {
        if (n_in != 13 || out_size != T * DM || ws_size < WS_END) { fprintf(stderr, "kernel_launch: unexpected shapes (n_in %d out %d ws %zu, need %zu)\n", n_in, out_size, ws_size, (size_t)WS_END); grid = -1; return; }
        int dev = 0, cus = 0, per_cu = 0;
        (void)hipGetDevice(&dev); (void)hipDeviceGetAttribute(&cus, hipDeviceAttributeMultiprocessorCount, dev);
        if (hipFuncSetAttribute((const void*)mega_fwd, hipFuncAttributeMaxDynamicSharedMemorySize, LDS_BYTES) != hipSuccess) { fprintf(stderr, "kernel_launch: hipFuncSetAttribute failed\n"); grid = -1; return; }
        if (hipOccupancyMaxActiveBlocksPerMultiprocessor(&per_cu, (const void*)mega_fwd, 512, LDS_BYTES) != hipSuccess || per_cu < 1) { fprintf(stderr, "kernel_launch: occupancy query says %d\n", per_cu); per_cu = 1; }
        (void)hipGetLastError();
        grid = cus * 1;
        if (grid > 256) grid = 256;
    }
    if (grid < 0) return;
    Params p{};
    p.x = (const float*)d_in[0]; p.mem = (const float*)d_in[1]; p.g_norm = (const float*)d_in[2]; p.w_in = (const float*)d_in[3]; p.diff_lambda = (const float*)d_in[4];
    p.w_mem_kv = (const float*)d_in[5]; p.g_mem = (const float*)d_in[6]; p.w_br_diff = (const float*)d_in[7]; p.w_br_dil = (const float*)d_in[8]; p.w_br_mem = (const float*)d_in[9];
    p.w_out = (const float*)d_in[10]; p.rel_bias = (const float*)d_in[11]; p.g_final = (const float*)d_in[12];
    p.out = (float*)d_out; p.ws = (unsigned char*)d_ws;
    if (hipMemsetAsync((unsigned char*)d_ws + WS_BAR, 0, XCD_BAR_WORDS * 4, stream) != hipSuccess) { fprintf(stderr, "kernel_launch: memset failed\n"); return; }
    void* args[] = {&p};
    hipError_t e = hipLaunchCooperativeKernel((const void*)mega_fwd, dim3(grid), dim3(512), args, LDS_BYTES, stream);
    if (e != hipSuccess) fprintf(stderr, "cooperative launch failed: %s (grid %d)\n", hipGetErrorString(e), grid);
}
```
